# Optimizing an MI355X kernel written in HIP

```python
import jax
import jax.numpy as jnp
from jax import lax
import numpy as np

D_MODEL = 2048
BATCH = 4
SEQ = 8192
DEPTH = 1

CTX_LEN = 256
GRID_W = 64
HEAD_DIM = D_MODEL // 16
N_HEADS_A = 8
N_KV_A = 2
GQA_GROUP = N_HEADS_A // N_KV_A
WINDOW = 128
BLOCK = 128
N_HEADS_B = 8
NB_ROWS = 8
NB_COLS = 16
D_FF = ((8 * D_MODEL // 3 + 255) // 256) * 256
CONV_W = 3
ROPE_BASE = 10000.0
EPS = 1e-6
NEG_INF = -1e30

W_QA = N_HEADS_A * HEAD_DIM
W_KA = N_KV_A * HEAD_DIM
W_B = N_HEADS_B * HEAD_DIM
SPLIT_WIDTHS = (W_QA, W_KA, W_KA, W_B, W_B, W_B, D_MODEL, D_MODEL)
SPLIT_POINTS = tuple(sum(SPLIT_WIDTHS[:i + 1]) for i in range(len(SPLIT_WIDTHS) - 1))
D_IN = sum(SPLIT_WIDTHS)

kernel_name = 'hybrid_dit_window_gqa_natten_convffn'


def rms_norm(x, g):
    xf = x.astype(jnp.float32)
    y = xf * lax.rsqrt(jnp.mean(jnp.square(xf), axis=-1, keepdims=True) + EPS)
    return (y * g.astype(jnp.float32)).astype(x.dtype)


def modulate(h, shift, scale):
    return h * (1 + scale) + shift


def axial_rope(t, row, col):
    half = t.shape[-1] // 2

    def rot(ta, pos):
        n = ta.shape[-1] // 2
        inv = ROPE_BASE ** (-jnp.arange(n, dtype=jnp.float32) / n)
        ang = pos.astype(jnp.float32)[:, None] * inv[None, :]
        cos = jnp.cos(ang)[None, :, None, :]
        sin = jnp.sin(ang)[None, :, None, :]
        t1 = ta[..., :n].astype(jnp.float32)
        t2 = ta[..., n:].astype(jnp.float32)
        return jnp.concatenate([t1 * cos - t2 * sin, t2 * cos + t1 * sin], axis=-1).astype(ta.dtype)

    return jnp.concatenate([rot(t[..., :half], row), rot(t[..., half:], col)], axis=-1)


def context_attention(qc, kc, vc, sink):
    b, l, kv, g, d = qc.shape
    s = jnp.einsum('bqkgd,bjkd->bkgqj', qc, kc, preferred_element_type=jnp.float32) * (d ** -0.5)
    if sink is not None:
        sink_col = jnp.broadcast_to(sink.astype(jnp.float32)[None, :, :, None, None], s.shape[:-1] + (1,))
        s = jnp.concatenate([s, sink_col], axis=-1)
    p = jax.nn.softmax(s, axis=-1)
    if sink is not None:
        p = p[..., :-1]
    o = jnp.einsum('bkgqj,bjkd->bqkgd', p.astype(vc.dtype), vc)
    return o.reshape(b, l, kv * g * d)


def window_gqa_latent(q, k, v, kc, vc, sink):
    b, s, _, d = q.shape
    nb = s // BLOCK
    scale = d ** -0.5
    qb = q.reshape(b, nb, BLOCK, N_KV_A, GQA_GROUP, d)

    def band(t):
        tp = jnp.pad(t, ((0, 0), (BLOCK, BLOCK), (0, 0), (0, 0))).reshape(b, nb + 2, BLOCK, N_KV_A, d)
        return jnp.concatenate([tp[:, :-2], tp[:, 1:-1], tp[:, 2:]], axis=2)

    kb, vb = band(k), band(v)
    s_loc = jnp.einsum('bnqkgd,bnjkd->bnkgqj', qb, kb, preferred_element_type=jnp.float32) * scale
    blk = jnp.arange(nb)[:, None, None]
    q_pos = blk * BLOCK + jnp.arange(BLOCK)[None, :, None]
    k_pos = (blk - 1) * BLOCK + jnp.arange(3 * BLOCK)[None, None, :]
    valid = (k_pos >= 0) & (k_pos < s) & (jnp.abs(k_pos - q_pos) <= WINDOW)
    s_loc = jnp.where(valid[None, :, None, None], s_loc, NEG_INF)
    s_ctx = jnp.einsum('bnqkgd,bjkd->bnkgqj', qb, kc, preferred_element_type=jnp.float32) * scale
    sink_col = jnp.broadcast_to(
        sink.reshape(N_KV_A, GQA_GROUP).astype(jnp.float32)[None, None, :, :, None, None],
        s_ctx.shape[:-1] + (1,))
    p = jax.nn.softmax(jnp.concatenate([s_loc, s_ctx, sink_col], axis=-1), axis=-1).astype(v.dtype)
    n_loc = 3 * BLOCK
    n_ctx = kc.shape[1]
    o = (jnp.einsum('bnkgqj,bnjkd->bnqkgd', p[..., :n_loc], vb)
         + jnp.einsum('bnkgqj,bjkd->bnqkgd', p[..., n_loc:n_loc + n_ctx], vc))
    return o.reshape(b, s, N_HEADS_A * d)


def neighbourhood_latent(q, k, v, kc, vc, rpb):
    b, s, h, d = q.shape
    rows = s // GRID_W
    kr = min(NB_ROWS, rows)
    scale = d ** -0.5
    r = jnp.arange(rows)
    row_idx = jnp.clip(r - kr // 2, 0, rows - kr)[:, None] + jnp.arange(kr)[None, :]
    cq = jnp.arange(GRID_W)
    col_start = jnp.clip(cq - NB_COLS // 2, 0, GRID_W - NB_COLS)
    col_valid = (cq[None, :] >= col_start[:, None]) & (cq[None, :] < col_start[:, None] + NB_COLS)
    qg = q.reshape(b, rows, GRID_W, h, d)
    kg = k.reshape(b, rows, GRID_W, h, d)[:, row_idx]
    vg = v.reshape(b, rows, GRID_W, h, d)[:, row_idx]
    s_nb = jnp.einsum('brqhd,brikhd->brhqik', qg, kg, preferred_element_type=jnp.float32) * scale
    dr = row_idx - r[:, None] + (NB_ROWS - 1)
    dc = jnp.clip(cq[None, :] - cq[:, None], -(NB_COLS - 1), NB_COLS - 1) + (NB_COLS - 1)
    bias = rpb[:, dr[:, :, None, None], dc[None, None, :, :]]
    bias = jnp.transpose(bias, (1, 0, 3, 2, 4)).astype(jnp.float32)
    s_nb = jnp.where(col_valid[:, None, :], s_nb + bias[None], NEG_INF)
    n_loc = kr * GRID_W
    s_nb = s_nb.reshape(b, rows, h, GRID_W, n_loc)
    s_ctx = jnp.einsum('brqhd,bjhd->brhqj', qg, kc, preferred_element_type=jnp.float32) * scale
    p = jax.nn.softmax(jnp.concatenate([s_nb, s_ctx], axis=-1), axis=-1).astype(v.dtype)
    p_nb = p[..., :n_loc].reshape(b, rows, h, GRID_W, kr, GRID_W)
    o = (jnp.einsum('brhqik,brikhd->brqhd', p_nb, vg)
         + jnp.einsum('brhqj,bjhd->brqhd', p[..., n_loc:], vc))
    return o.reshape(b, s, h * d)


def mixer_sublayer(h, hc, w_in, sink_a, rpb_b, w_br_a, w_br_b, w_o, need_ctx):
    b, s, _ = h.shape
    l = hc.shape[1]
    t = jnp.arange(s)
    row, col = t // GRID_W, t % GRID_W
    qa, ka, va, qb, kb, vb, ga, gb = jnp.split(h @ w_in, SPLIT_POINTS, axis=-1)
    qa_c, ka_c, va_c, qb_c, kb_c, vb_c, ga_c, gb_c = jnp.split(hc @ w_in, SPLIT_POINTS, axis=-1)

    qa = axial_rope(qa.reshape(b, s, N_HEADS_A, HEAD_DIM), row, col)
    ka = axial_rope(ka.reshape(b, s, N_KV_A, HEAD_DIM), row, col)
    va = va.reshape(b, s, N_KV_A, HEAD_DIM)
    ka_c = ka_c.reshape(b, l, N_KV_A, HEAD_DIM)
    va_c = va_c.reshape(b, l, N_KV_A, HEAD_DIM)
    qb = qb.reshape(b, s, N_HEADS_B, HEAD_DIM)
    kb = kb.reshape(b, s, N_HEADS_B, HEAD_DIM)
    vb = vb.reshape(b, s, N_HEADS_B, HEAD_DIM)
    kb_c = kb_c.reshape(b, l, N_HEADS_B, HEAD_DIM)
    vb_c = vb_c.reshape(b, l, N_HEADS_B, HEAD_DIM)

    oa = window_gqa_latent(qa, ka, va, ka_c, va_c, sink_a)
    ob = neighbourhood_latent(qb, kb, vb, kb_c, vb_c, rpb_b)
    y = (jax.nn.sigmoid(ga) * (oa @ w_br_a) + jax.nn.sigmoid(gb) * (ob @ w_br_b)) @ w_o

    yc = None
    if need_ctx:
        oa_c = context_attention(qa_c.reshape(b, l, N_KV_A, GQA_GROUP, HEAD_DIM), ka_c, va_c,
                                 sink_a.reshape(N_KV_A, GQA_GROUP))
        ob_c = context_attention(qb_c.reshape(b, l, N_HEADS_B, 1, HEAD_DIM), kb_c, vb_c, None)
        yc = (jax.nn.sigmoid(ga_c) * (oa_c @ w_br_a) + jax.nn.sigmoid(gb_c) * (ob_c @ w_br_b)) @ w_o
    return y, yc


def depthwise_conv(u, w, bias):
    pad = CONV_W // 2
    t = u.shape[1]
    up = jnp.pad(u, ((0, 0), (pad, pad), (0, 0)))
    out = bias
    for j in range(CONV_W):
        out = out + up[:, j:j + t] * w[j]
    return out


def conv_ffn(h, w_up, conv_w, conv_b, w_down):
    u = depthwise_conv(h @ w_up, conv_w, conv_b)
    a, g = jnp.split(u, 2, axis=-1)
    return (jax.nn.silu(g) * a) @ w_down


def setup_inputs(seed: int = 0) -> dict:
    key = jax.random.key(seed)
    ks = jax.random.split(key, 20)

    def nrm(k, shape, scale):
        return jax.random.normal(k, shape, jnp.float32) * scale

    def gain(k):
        return 1.0 + nrm(k, (DEPTH, D_MODEL), 0.05)

    return {
        'x': nrm(ks[0], (BATCH, SEQ, D_MODEL), 1.0),
        'c': nrm(ks[1], (BATCH, D_MODEL), 1.0),
        'ctx': nrm(ks[2], (BATCH, CTX_LEN, D_MODEL), 1.0),
        'c_ctx': nrm(ks[3], (D_MODEL,), 1.0),
        'w_mod': nrm(ks[4], (DEPTH, D_MODEL, 6 * D_MODEL), D_MODEL ** -0.5),
        'b_mod': nrm(ks[5], (DEPTH, 6 * D_MODEL), 0.01),
        'g_attn_pre': gain(ks[6]),
        'g_attn_post': gain(ks[7]),
        'g_ffn_pre': gain(ks[8]),
        'g_ffn_post': gain(ks[9]),
        'w_in': nrm(ks[10], (DEPTH, D_MODEL, D_IN), D_MODEL ** -0.5),
        'sink_a': nrm(ks[11], (DEPTH, N_HEADS_A), 1.0),
        'rpb_b': nrm(ks[12], (DEPTH, N_HEADS_B, 2 * NB_ROWS - 1, 2 * NB_COLS - 1), 0.5),
        'w_br_a': nrm(ks[13], (DEPTH, W_QA, D_MODEL), W_QA ** -0.5),
        'w_br_b': nrm(ks[14], (DEPTH, W_B, D_MODEL), W_B ** -0.5),
        'w_o': nrm(ks[15], (DEPTH, D_MODEL, D_MODEL), D_MODEL ** -0.5),
        'w_up': nrm(ks[16], (DEPTH, D_MODEL, 2 * D_FF), D_MODEL ** -0.5),
        'conv_w': nrm(ks[17], (DEPTH, CONV_W, 2 * D_FF), CONV_W ** -0.5),
        'conv_b': nrm(ks[18], (DEPTH, 2 * D_FF), 0.01),
        'w_down': nrm(ks[19], (DEPTH, D_FF, D_MODEL), D_FF ** -0.5),
    }


def reference(x, c, ctx, c_ctx, w_mod, b_mod, g_attn_pre, g_attn_post, g_ffn_pre, g_ffn_post,
              w_in, sink_a, rpb_b, w_br_a, w_br_b, w_o, w_up, conv_w, conv_b, w_down):
    for l in range(DEPTH):
        need_ctx = l < DEPTH - 1
        mod = jax.nn.silu(c) @ w_mod[l] + b_mod[l]
        mod_c = jax.nn.silu(c_ctx) @ w_mod[l] + b_mod[l]
        sh1, sc1, gt1, sh2, sc2, gt2 = [m[:, None, :] for m in jnp.split(mod, 6, axis=-1)]
        csh1, csc1, cgt1, csh2, csc2, cgt2 = jnp.split(mod_c, 6, axis=-1)

        h = modulate(rms_norm(x, g_attn_pre[l]), sh1, sc1)
        hc = modulate(rms_norm(ctx, g_attn_pre[l]), csh1, csc1)
        y, yc = mixer_sublayer(h, hc, w_in[l], sink_a[l], rpb_b[l], w_br_a[l], w_br_b[l], w_o[l], need_ctx)
        x = x + gt1 * rms_norm(y, g_attn_post[l])

        h = modulate(rms_norm(x, g_ffn_pre[l]), sh2, sc2)
        x = x + gt2 * rms_norm(conv_ffn(h, w_up[l], conv_w[l], conv_b[l], w_down[l]), g_ffn_post[l])

        if need_ctx:
            ctx = ctx + cgt1 * rms_norm(yc, g_attn_post[l])
            hc = modulate(rms_norm(ctx, g_ffn_pre[l]), csh2, csc2)
            ctx = ctx + cgt2 * rms_norm(conv_ffn(hc, w_up[l], conv_w[l], conv_b[l], w_down[l]), g_ffn_post[l])
    return x
```

```cpp
#include <hip/hip_runtime.h>
#include <hip/hip_cooperative_groups.h>
#include <cstdio>
#include <cstdint>
namespace cg = cooperative_groups;

#ifndef MK_N_LAUNCHES
#define MK_N_LAUNCHES 1
#endif

#define LAS __attribute__((address_space(3)))
typedef unsigned short bf16_t;
typedef short bf16x8 __attribute__((ext_vector_type(8)));
typedef short s16x4 __attribute__((ext_vector_type(4)));
typedef float f32x4 __attribute__((ext_vector_type(4)));
typedef float f32x2 __attribute__((ext_vector_type(2)));
typedef float f32x16 __attribute__((ext_vector_type(16)));
typedef unsigned u32x4 __attribute__((ext_vector_type(4)));
typedef unsigned u32x2 __attribute__((ext_vector_type(2)));

constexpr int DM = 2048, NBATCH = 4, SEQ = 8192, CTXL = 256;
constexpr int MTOK = NBATCH * SEQ;
constexpr int MCTX = NBATCH * CTXL;
constexpr int MALL = MTOK + MCTX;
constexpr int DIN = 8704, DFF = 5632, DUP = 2 * DFF;
constexpr int C_QA = 0, C_KA = 1024, C_VA = 1280, C_QB = 1536, C_KB = 2560, C_VB = 3584, C_GA = 4608, C_GB = 6656;
constexpr int NMOD = 6 * DM;
constexpr float EPS = 1e-6f;
constexpr float LOG2E = 1.4426950408889634f;
constexpr float QSCALE = 0.08838834764831845f * LOG2E;
constexpr float NEGBIG = -1e30f;

constexpr size_t MiB = 1u << 20;
constexpr size_t WS_BAR = 16384, CTL_ZERO_BYTES = 64 * 1024;
constexpr size_t WS_MOD = 64 * 1024;
constexpr size_t WS_ROPEC = 512 * 1024;
constexpr size_t WS_ROPES = 768 * 1024;
constexpr size_t WS_WIN = 4 * MiB;
constexpr size_t WS_WBA = 38 * MiB;
constexpr size_t WS_WBB = 42 * MiB;
constexpr size_t WS_WO = 46 * MiB;
constexpr size_t WS_WUP = 54 * MiB;
constexpr size_t WS_WDN = 98 * MiB;
constexpr size_t WS_H = 120 * MiB;
constexpr size_t WS_OAB = 252 * MiB;
constexpr size_t WS_QKVG = 380 * MiB;
constexpr size_t WS_Y = 380 * MiB;
constexpr size_t WS_ACT = 508 * MiB;
constexpr size_t WS_HALO = 860 * MiB;
constexpr size_t WS_END = 941 * MiB;

constexpr int LDS_BYTES = 147456;

__device__ __forceinline__ unsigned cvt_pk_bf16(float lo, float hi) { unsigned r; asm volatile("v_cvt_pk_bf16_f32 %0, %1, %2" : "=v"(r) : "v"(lo), "v"(hi)); return r; }
__device__ __forceinline__ float bf_lo(unsigned w) { return __uint_as_float(w << 16); }
__device__ __forceinline__ float bf_hi(unsigned w) { return __uint_as_float(w & 0xffff0000u); }
__device__ __forceinline__ float wave_sum(float v) {
#pragma unroll
    for (int o = 1; o < 64; o <<= 1) v += __shfl_xor(v, o);
    return v;
}
__device__ __forceinline__ float sigmoidf_(float x) { return __builtin_amdgcn_rcpf(1.0f + __builtin_amdgcn_exp2f(-x * LOG2E)); }
template <int CTRL> __device__ __forceinline__ float dppf(float old, float src) {
    return __int_as_float(__builtin_amdgcn_update_dpp(__float_as_int(old), __float_as_int(src), CTRL, 0xf, 0xf, false));
}


#define XB_TMO      128
#define XB_XCNT(j)  (256  + 64 * (j))
#define XB_XSUB(j)  (1280 + 64 * (j))
#define XB_XGEN(j)  (2304 + 64 * (j))
#define XB_TOP      3328
#define XB_TOPGEN   3392
#define XCD_BAR_WORDS 3456
#define XB_SPIN_CAP (1u << 18)
__device__ __forceinline__ unsigned xb_ld(unsigned* p)              { return __hip_atomic_load(p, __ATOMIC_RELAXED, __HIP_MEMORY_SCOPE_AGENT); }
__device__ __forceinline__ unsigned xb_add(unsigned* p, unsigned v) { return __hip_atomic_fetch_add(p, v, __ATOMIC_RELAXED, __HIP_MEMORY_SCOPE_AGENT); }
__device__ __forceinline__ unsigned xb_xcc_id() { return (unsigned)__builtin_amdgcn_s_getreg((3 << 11) | 20) & 0xFu; }
#define XB_SPIN(cond, bar) do { unsigned _sp = 0; while (cond) { __builtin_amdgcn_s_sleep(1); \
    if ((++_sp & 255u) == 0u) { if (xb_ld(&(bar)[XB_TMO])) break; if (_sp > XB_SPIN_CAP) { atomicAdd(&(bar)[XB_TMO], 1u); break; } } } } while (0)
struct XcdBarrier { unsigned* bar; unsigned x; volatile LAS unsigned* st; };
__device__ __forceinline__ XcdBarrier xcd_barrier_post(unsigned* bar, volatile LAS unsigned* st) {
    XcdBarrier b; b.bar = bar; b.x = xb_xcc_id(); b.st = st;
    if (threadIdx.x == 0) (void)xb_add(&bar[XB_XCNT(b.x)], 1u);
    return b;
}
__device__ __forceinline__ void xcd_barrier_complete(unsigned* bar, unsigned x, unsigned& nloc, unsigned& nx) {
    const unsigned G = gridDim.x * gridDim.y * gridDim.z;
    unsigned sum, cnt, mine, sp = 0u;
    for (;;) {
        sum = 0u; cnt = 0u; mine = 0u;
#pragma unroll
        for (unsigned j = 0; j < 16; ++j) { const unsigned c = xb_ld(&bar[XB_XCNT(j)]); sum += c; cnt += (c > 0u) ? 1u : 0u; mine = (j == x) ? c : mine; }
        if (sum == G) break;
        __builtin_amdgcn_s_sleep(1);
        if ((++sp & 255u) == 0u) { if (xb_ld(&bar[XB_TMO])) break; if (sp > XB_SPIN_CAP) { atomicAdd(&bar[XB_TMO], 1u); break; } }
    }
    nloc = mine > 0u ? mine : 1u; nx = cnt > 0u ? cnt : 1u;
}
__device__ __forceinline__ void xcd_barrier(const XcdBarrier& b) {
    asm volatile("s_waitcnt vmcnt(0)" ::: "memory");
    __syncthreads();
    if (threadIdx.x == 0) {
        unsigned* bar = b.bar;
        __builtin_amdgcn_s_waitcnt(0);
        unsigned nloc = b.st[0], nx = b.st[1];
        if (nloc == 0u) { xcd_barrier_complete(bar, b.x, nloc, nx); b.st[0] = nloc; b.st[1] = nx; }
        const unsigned old = xb_add(&bar[XB_XSUB(b.x)], 1u);
        const unsigned gen = old / nloc;
        if (old + 1u == (gen + 1u) * nloc) {
            __builtin_amdgcn_fence(__ATOMIC_RELEASE, "agent");
            asm volatile("s_waitcnt vmcnt(0)" ::: "memory");
            const unsigned og = xb_add(&bar[XB_TOP], 1u);
            const unsigned tg = og / nx;
            if (og + 1u == (tg + 1u) * nx) xb_add(&bar[XB_TOPGEN], 1u);
            else XB_SPIN(xb_ld(&bar[XB_TOPGEN]) == tg, bar);
            __builtin_amdgcn_fence(__ATOMIC_ACQUIRE, "agent");
            xb_add(&bar[XB_XGEN(b.x)], 1u);
            asm volatile("s_waitcnt vmcnt(0)" ::: "memory");
        } else {
            XB_SPIN(xb_ld(&bar[XB_XGEN(b.x)]) == gen, bar);
            __builtin_amdgcn_fence(__ATOMIC_ACQUIRE, "agent");
            asm volatile("s_waitcnt vmcnt(0)" ::: "memory");
        }
    }
    __syncthreads();
}

namespace pg8 {
constexpr int BM = 256, BK = 64, HALF = 128, HTB = HALF * BK * 2, STAGE_BYTES = 8 * HTB, NXCD = 8, WGM = 8;
__host__ __device__ __forceinline__ int lds_byte(int r, int c) { const int st = (r >> 4) * 2 + (c >> 5), rr = r & 15, cc = c & 31, ob = rr * 64 + cc * 2; return st * 1024 + (ob ^ (((ob >> 9) & 1) << 5)); }
__host__ __device__ __forceinline__ void stage_rc(int b, int& R, int& C) { const int st = b / 1024, sb = b % 1024, swz = sb ^ (((sb >> 9) & 1) << 5); R = (st >> 1) * 16 + swz / 64; C = (st & 1) * 32 + (swz % 64) / 2; }
__host__ __device__ __forceinline__ int perm32(int rho) { const int n = rho >> 4, i = rho & 15; return 8 * (i >> 2) + 4 * n + (i & 3); }

struct Unit { int pm, pn, seg; };
struct Gemm { const bf16_t* A; const bf16_t* Bt; int lda, ldb, K; const bf16_t* A2; const bf16_t* Bt2; };

struct Order {
    int nM, nN, nwg, G, c, extra, twoseg;
    __device__ void init(int nM_, int nN_, int G_, int c_, int extra_, int twoseg_ = 0) { nM = nM_; nN = nN_; nwg = nM * nN; G = G_; c = c_; extra = extra_; twoseg = twoseg_; }
    __device__ bool next(int i, Unit& u) const {
        u.seg = twoseg ? (i & 1) : 0; if (twoseg) i >>= 1;
        const long L = (long)i * G + c; if (L >= nwg + extra) return false;
        if (L >= nwg) { const int idx = (int)L - nwg, k = idx % 10; u.pm = 128 + idx / 10; u.pn = k < 2 ? 4 + k : 8 + k; return true; }
        int wgid = (int)L; { const int q = nwg / NXCD, r = nwg % NXCD, xcd = wgid % NXCD, off = wgid / NXCD; wgid = (xcd < r ? xcd * (q + 1) : r * (q + 1) + (xcd - r) * q) + off; }
        const int nig = WGM * nN, gid = wgid / nig, fm = gid * WGM, gsz = (nM - fm) < WGM ? (nM - fm) : WGM;
        u.pm = fm + ((wgid % nig) % gsz); u.pn = (wgid % nig) / gsz; return true;
    }
};

typedef f32x4 Acc[2][2][4][2];

struct EpiBf16 {
    static constexpr bool PERM = true;
    __device__ __forceinline__ static bool keep_acc(const Unit&) { return false; }
    bf16_t* O; int ldc;
    __device__ __forceinline__ void operator()(Acc& acc, const Unit& u, int wr, int wc, int fr, int fq) const {
        const int row0 = u.pm * BM + wr * 64 + fr, col0 = u.pn * BM + wc * 32 + 8 * fq;
#pragma unroll
        for (int ai = 0; ai < 2; ++ai)
#pragma unroll
            for (int m = 0; m < 4; ++m) { bf16_t* rowp = O + (size_t)(row0 + ai * HALF + m * 16) * ldc + col0;
#pragma unroll
                for (int bj = 0; bj < 2; ++bj) { const f32x4 v0 = acc[ai][bj][m][0], v1 = acc[ai][bj][m][1];
                    u32x4 w; w.x = cvt_pk_bf16(v0[0], v0[1]); w.y = cvt_pk_bf16(v0[2], v0[3]); w.z = cvt_pk_bf16(v1[0], v1[1]); w.w = cvt_pk_bf16(v1[2], v1[3]);
                    *(u32x4*)(rowp + bj * HALF) = w; } }
    }
};

struct EpiQKV {
    static constexpr bool PERM = true;
    __device__ __forceinline__ static bool keep_acc(const Unit&) { return false; }
    bf16_t* O; const float* rc; const float* rs;
    __device__ __forceinline__ void operator()(Acc& acc, const Unit& u, int wr, int wc, int fr, int fq) const {
        const int pn = u.pn; int mode = 0;
        if (pn <= 4) mode = (u.pm < 128) ? 1 : 0; else if (pn >= 6 && pn <= 9) mode = 2; else if (pn >= 18) mode = 3;
        const float qs = (pn < 4 || mode == 2) ? QSCALE : 1.0f;
        const int row0 = u.pm * BM + wr * 64 + fr, col0 = pn * BM + wc * 32 + 8 * fq;
        const int ridx = 16 * (wc & 1) + 4 * fq;
        f32x4 cq[2][4], sq[2][4];
#pragma unroll
        for (int ai = 0; ai < 2; ++ai)
#pragma unroll
            for (int m = 0; m < 4; ++m) { cq[ai][m] = (f32x4){1.f, 1.f, 1.f, 1.f}; sq[ai][m] = (f32x4){0.f, 0.f, 0.f, 0.f};
                if (mode == 1) { const int t = (row0 + ai * HALF + m * 16) & (SEQ - 1); const int pos = (wc >> 1) ? (t & 63) : (t >> 6); cq[ai][m] = *(const f32x4*)(rc + pos * 32 + ridx); sq[ai][m] = *(const f32x4*)(rs + pos * 32 + ridx); } }
#pragma unroll
        for (int ai = 0; ai < 2; ++ai)
#pragma unroll
            for (int m = 0; m < 4; ++m) { const int row = row0 + ai * HALF + m * 16; bf16_t* rowp = O + (size_t)row * DIN + col0;
                const f32x4 c4 = cq[ai][m], s4 = sq[ai][m];
#pragma unroll
                for (int bj = 0; bj < 2; ++bj) { f32x4 v0 = acc[ai][bj][m][0], v1 = acc[ai][bj][m][1];
                    if (mode == 1) { const f32x4 o0 = v0 * c4 - v1 * s4, o1 = v1 * c4 + v0 * s4; v0 = o0 * qs; v1 = o1 * qs; }
                    else if (mode == 2) { v0 = v0 * qs; v1 = v1 * qs; }
                    else if (mode == 3) {
#pragma unroll
                        for (int e = 0; e < 4; ++e) { v0[e] = sigmoidf_(v0[e]); v1[e] = sigmoidf_(v1[e]); } }
                    u32x4 w; w.x = cvt_pk_bf16(v0[0], v0[1]); w.y = cvt_pk_bf16(v0[2], v0[3]); w.z = cvt_pk_bf16(v1[0], v1[1]); w.w = cvt_pk_bf16(v1[2], v1[3]);
                    *(u32x4*)(rowp + bj * HALF) = w; } }
    }
};

struct EpiBranch2 {
    static constexpr bool PERM = true;
    __device__ __forceinline__ static bool keep_acc(const Unit& u) { return u.seg == 0; }
    bf16_t* Z; const bf16_t* GA; const bf16_t* GB;
    __device__ __forceinline__ void operator()(Acc& acc, const Unit& u, int wr, int wc, int fr, int fq) const {
        const int row0 = u.pm * BM + wr * 64 + fr, col0 = u.pn * BM + wc * 32 + 8 * fq;
        if (u.seg == 0) {
#pragma unroll
            for (int ai = 0; ai < 2; ++ai)
#pragma unroll
                for (int m = 0; m < 4; ++m) { const size_t ro = (size_t)(row0 + ai * HALF + m * 16) * DIN + col0;
#pragma unroll
                    for (int bj = 0; bj < 2; ++bj) { const u32x4 ga = *(const u32x4*)(GA + ro + bj * HALF), gb = *(const u32x4*)(GB + ro + bj * HALF);
                        f32x4 r0, r1;
                        r0[0] = bf_lo(ga.x) * __builtin_amdgcn_rcpf(fmaxf(bf_lo(gb.x), 1e-20f)); r0[1] = bf_hi(ga.x) * __builtin_amdgcn_rcpf(fmaxf(bf_hi(gb.x), 1e-20f));
                        r0[2] = bf_lo(ga.y) * __builtin_amdgcn_rcpf(fmaxf(bf_lo(gb.y), 1e-20f)); r0[3] = bf_hi(ga.y) * __builtin_amdgcn_rcpf(fmaxf(bf_hi(gb.y), 1e-20f));
                        r1[0] = bf_lo(ga.z) * __builtin_amdgcn_rcpf(fmaxf(bf_lo(gb.z), 1e-20f)); r1[1] = bf_hi(ga.z) * __builtin_amdgcn_rcpf(fmaxf(bf_hi(gb.z), 1e-20f));
                        r1[2] = bf_lo(ga.w) * __builtin_amdgcn_rcpf(fmaxf(bf_lo(gb.w), 1e-20f)); r1[3] = bf_hi(ga.w) * __builtin_amdgcn_rcpf(fmaxf(bf_hi(gb.w), 1e-20f));
                        acc[ai][bj][m][0] *= r0; acc[ai][bj][m][1] *= r1; } }
        } else {
            u32x4 gq[2][4][2];
#pragma unroll
            for (int ai = 0; ai < 2; ++ai)
#pragma unroll
                for (int m = 0; m < 4; ++m)
#pragma unroll
                    for (int bj = 0; bj < 2; ++bj) gq[ai][m][bj] = *(const u32x4*)(GB + (size_t)(row0 + ai * HALF + m * 16) * DIN + col0 + bj * HALF);
#pragma unroll
            for (int ai = 0; ai < 2; ++ai)
#pragma unroll
                for (int m = 0; m < 4; ++m) { const int row = row0 + ai * HALF + m * 16; bf16_t* zp = Z + (size_t)row * DM + col0;
#pragma unroll
                    for (int bj = 0; bj < 2; ++bj) { f32x4 v0 = acc[ai][bj][m][0], v1 = acc[ai][bj][m][1];
                        const u32x4 g = gq[ai][m][bj];
                        v0[0] *= fmaxf(bf_lo(g.x), 1e-20f); v0[1] *= fmaxf(bf_hi(g.x), 1e-20f); v0[2] *= fmaxf(bf_lo(g.y), 1e-20f); v0[3] *= fmaxf(bf_hi(g.y), 1e-20f);
                        v1[0] *= fmaxf(bf_lo(g.z), 1e-20f); v1[1] *= fmaxf(bf_hi(g.z), 1e-20f); v1[2] *= fmaxf(bf_lo(g.w), 1e-20f); v1[3] *= fmaxf(bf_hi(g.w), 1e-20f);
                        u32x4 w; w.x = cvt_pk_bf16(v0[0], v0[1]); w.y = cvt_pk_bf16(v0[2], v0[3]); w.z = cvt_pk_bf16(v1[0], v1[1]); w.w = cvt_pk_bf16(v1[2], v1[3]);
                        *(u32x4*)(zp + bj * HALF) = w; } }
        }
    }
};

struct EpiUp {
    static constexpr bool PERM = true;
    __device__ __forceinline__ static bool keep_acc(const Unit&) { return false; }
    bf16_t* ACT; bf16_t* HALO; const float* cw; const float* cb;
    __device__ __forceinline__ void operator()(Acc& acc, const Unit& u, int wr, int wc, int fr, int fq) const {
        const int cc = wc * 32 + 8 * fq, acol = u.pn * HALF + cc;
        f32x4 cwa[2][4], cwg[2][4];
#pragma unroll
        for (int n = 0; n < 2; ++n) { const int ca = acol + 4 * n, cg_ = DFF + acol + 4 * n;
            cwa[n][0] = *(const f32x4*)(cw + ca); cwa[n][1] = *(const f32x4*)(cw + DUP + ca); cwa[n][2] = *(const f32x4*)(cw + 2 * DUP + ca); cwa[n][3] = *(const f32x4*)(cb + ca);
            cwg[n][0] = *(const f32x4*)(cw + cg_); cwg[n][1] = *(const f32x4*)(cw + DUP + cg_); cwg[n][2] = *(const f32x4*)(cw + 2 * DUP + cg_); cwg[n][3] = *(const f32x4*)(cb + cg_); }
#pragma unroll
        for (int ai = 0; ai < 2; ++ai) { const int chunk = u.pm * 4 + ai * 2 + wr;
            if (fr < 2 || fr >= 14) { const int slot = fr < 2 ? fr : fr - 12;
                bf16_t* hp = HALO + ((size_t)(chunk * 4 + slot) * DUP + u.pn * BM + cc);
#pragma unroll
                for (int bj = 0; bj < 2; ++bj) { const f32x4 v0 = fr < 2 ? acc[ai][bj][0][0] : acc[ai][bj][3][0], v1 = fr < 2 ? acc[ai][bj][0][1] : acc[ai][bj][3][1];
                    u32x4 w; w.x = cvt_pk_bf16(v0[0], v0[1]); w.y = cvt_pk_bf16(v0[2], v0[3]); w.z = cvt_pk_bf16(v1[0], v1[1]); w.w = cvt_pk_bf16(v1[2], v1[3]);
                    *(u32x4*)(hp + bj * HALF) = w; } } }
#pragma unroll
        for (int n = 0; n < 2; ++n) {
            const f32x4 wa0 = cwa[n][0], wa1 = cwa[n][1], wa2 = cwa[n][2], ba = cwa[n][3];
            const f32x4 wg0 = cwg[n][0], wg1 = cwg[n][1], wg2 = cwg[n][2], bg = cwg[n][3];
#pragma unroll
            for (int k = 0; k < 4; ++k)
#pragma unroll
                for (int ai = 0; ai < 2; ++ai) {
                    float ra[4], rg[4], pa[4], pg[4], na[4], ng[4];
#pragma unroll
                    for (int m = 0; m < 4; ++m) { ra[m] = acc[ai][0][m][n][k]; rg[m] = acc[ai][1][m][n][k]; }
#pragma unroll
                    for (int m = 0; m < 4; ++m) {
                        const float oa = m > 0 ? dppf<0x121>(ra[m - 1], ra[m - 1]) : 0.f, og = m > 0 ? dppf<0x121>(rg[m - 1], rg[m - 1]) : 0.f;
                        pa[m] = dppf<0x111>(oa, ra[m]); pg[m] = dppf<0x111>(og, rg[m]);
                        const float qa = m < 3 ? dppf<0x12F>(ra[m + 1], ra[m + 1]) : 0.f, qg = m < 3 ? dppf<0x12F>(rg[m + 1], rg[m + 1]) : 0.f;
                        na[m] = dppf<0x101>(qa, ra[m]); ng[m] = dppf<0x101>(qg, rg[m]);
                    }
#pragma unroll
                    for (int m = 0; m < 4; ++m) {
                        const float va = ba[k] + wa0[k] * pa[m] + wa1[k] * ra[m] + wa2[k] * na[m];
                        const float vg = bg[k] + wg0[k] * pg[m] + wg1[k] * rg[m] + wg2[k] * ng[m];
                        acc[ai][0][m][n][k] = va * vg * sigmoidf_(vg);
                    }
                }
        }
        const int row0 = u.pm * BM + wr * 64 + fr;
#pragma unroll
        for (int ai = 0; ai < 2; ++ai)
#pragma unroll
            for (int m = 0; m < 4; ++m) { const f32x4 v0 = acc[ai][0][m][0], v1 = acc[ai][0][m][1];
                u32x4 w; w.x = cvt_pk_bf16(v0[0], v0[1]); w.y = cvt_pk_bf16(v0[2], v0[3]); w.z = cvt_pk_bf16(v1[0], v1[1]); w.w = cvt_pk_bf16(v1[2], v1[3]);
                *(u32x4*)(ACT + (size_t)(row0 + ai * HALF + m * 16) * DFF + acol) = w; }
    }
};

template <class Epi, class Sched, bool ALIGN_EPI, bool SP2>
__device__ __forceinline__ void gemm_phase(LAS unsigned char* lds, const Gemm g, const Sched& S, const Epi& E) {
    int tid = threadIdx.x; asm volatile("" : "+v"(tid));
    const int wid = __builtin_amdgcn_readfirstlane(tid >> 6), lane = tid & 63, wr = wid >> 2, wc = wid & 3, fr = lane & 15, fq = lane >> 4;
    const int K = g.K, nt = K / BK;
    unsigned voffA[2], voffB[2];
#pragma unroll
    for (int i = 0; i < 2; ++i) { int R, C; stage_rc(tid * 16 + i * 8192, R, C); const int Rb = Epi::PERM ? ((R & ~31) + perm32(R & 31)) : R;
        voffA[i] = (unsigned)(R * g.lda + C) * 2u; voffB[i] = (unsigned)(Rb * g.ldb + C) * 2u; }
    const size_t kstep = (size_t)(BK * 2);
    const size_t hA = (size_t)HALF * g.lda * 2, hB = (size_t)HALF * g.ldb * 2;
    const size_t tA = 2 * hA, tB = 2 * hB;
    const unsigned ldsw = (unsigned)wid * 1024u;
    const int aoff = lds_byte(wr * 64 + fr, fq * 8), boff = lds_byte(wc * 32 + fr, fq * 8);
#define PG8_SA(b, h) (((b) * 2 + (h)) * HTB)
#define PG8_SB(b, h) ((4 + (b) * 2 + (h)) * HTB)
#define PG8_STAGE(bufoff, gbase, voff) do { _Pragma("unroll") for (int _i = 0; _i < 2; ++_i) \
        __builtin_amdgcn_global_load_lds((const unsigned*)((const char*)(gbase) + (voff)[_i]), (LAS unsigned*)(lds + (bufoff) + ldsw + _i * 8192), 16, 0, 0); } while (0)
#define PG8_LDA(dst, b, h) do { _Pragma("unroll") for (int m = 0; m < 4; ++m) _Pragma("unroll") for (int k = 0; k < 2; ++k) dst[m][k] = *(const LAS bf16x8*)(lds + PG8_SA(b, h) + aoff + m * 2048 + k * 1024); } while (0)
#define PG8_LDB(dst, b, h) do { _Pragma("unroll") for (int n = 0; n < 2; ++n) _Pragma("unroll") for (int k = 0; k < 2; ++k) dst[n][k] = *(const LAS bf16x8*)(lds + PG8_SB(b, h) + boff + n * 2048 + k * 1024); } while (0)
#define PG8_MMA(ai, bj, At, Bt) do { __builtin_amdgcn_s_setprio(1); _Pragma("unroll") for (int m = 0; m < 4; ++m) _Pragma("unroll") for (int n = 0; n < 2; ++n) _Pragma("unroll") for (int k = 0; k < 2; ++k) \
        acc[ai][bj][m][n] = __builtin_amdgcn_mfma_f32_16x16x32_bf16(Bt[n][k], At[m][k], acc[ai][bj][m][n], 0, 0, 0); __builtin_amdgcn_s_setprio(0); } while (0)
#define PG8_WAIT_V(n) asm volatile("s_waitcnt vmcnt(" #n ")" ::: "memory")
#define PG8_WAIT_L(n) asm volatile("s_waitcnt lgkmcnt(" #n ")" ::: "memory")
#define PG8_BAR __builtin_amdgcn_s_barrier()
#define PG8_SCHED __builtin_amdgcn_sched_barrier(0)
    Unit cur, nxt; int ui = 0;
    if (!S.next(0, cur)) return;
    Acc acc;
#pragma unroll
    for (int a = 0; a < 2; ++a)
#pragma unroll
        for (int b = 0; b < 2; ++b)
#pragma unroll
            for (int m = 0; m < 4; ++m)
#pragma unroll
                for (int n = 0; n < 2; ++n) acc[a][b][m][n] = (f32x4){0.f, 0.f, 0.f, 0.f};
    bf16x8 At[4][2], B0[2][2], B1[2][2];
    const char* cA = (const char*)(cur.seg ? g.A2 : g.A) + (size_t)cur.pm * tA; const char* cB = (const char*)(cur.seg ? g.Bt2 : g.Bt) + (size_t)cur.pn * tB;
    if constexpr (SP2) {
        PG8_STAGE(PG8_SB(0, 0), cB, voffB); PG8_STAGE(PG8_SB(0, 1), cB + hB, voffB); PG8_STAGE(PG8_SA(0, 0), cA, voffA); PG8_STAGE(PG8_SA(0, 1), cA + hA, voffA);
        if (wr == 1) PG8_BAR;
        PG8_WAIT_V(2); PG8_BAR;
        PG8_STAGE(PG8_SB(1, 0), cB + kstep, voffB); PG8_STAGE(PG8_SA(1, 0), cA + kstep, voffA); PG8_STAGE(PG8_SB(1, 1), cB + hB + kstep, voffB);
        PG8_WAIT_V(6); PG8_BAR;
    } else {
        PG8_STAGE(PG8_SB(0, 0), cB, voffB); PG8_STAGE(PG8_SA(0, 0), cA, voffA); PG8_STAGE(PG8_SB(0, 1), cB + hB, voffB); PG8_STAGE(PG8_SA(0, 1), cA + hA, voffA);
        if (wr == 1) PG8_BAR;
        PG8_WAIT_V(4); PG8_BAR;
        PG8_STAGE(PG8_SB(1, 0), cB + kstep, voffB); PG8_STAGE(PG8_SA(1, 0), cA + kstep, voffA); PG8_STAGE(PG8_SB(1, 1), cB + hB + kstep, voffB);
        PG8_WAIT_V(6); PG8_BAR;
    }
    for (;;) {
        const bool has_next = S.next(ui + 1, nxt);
        const char* nA = has_next ? (const char*)(nxt.seg ? g.A2 : g.A) + (size_t)nxt.pm * tA : cA; const char* nB = has_next ? (const char*)(nxt.seg ? g.Bt2 : g.Bt) + (size_t)nxt.pn * tB : cB;
        for (int t = 0; t < nt; t += 2) {
            const bool last = (t == nt - 2);
            const char* a1 = cA + (size_t)(t + 1) * kstep;
            const char* a2 = last ? nA : cA + (size_t)(t + 2) * kstep; const char* b2 = last ? nB : cB + (size_t)(t + 2) * kstep;
            const char* a3 = a2 + kstep; const char* b3 = b2 + kstep;
            if constexpr (SP2) {
            PG8_LDB(B0, 0, 0); PG8_LDB(B1, 0, 1); PG8_SCHED; PG8_LDA(At, 0, 0); PG8_STAGE(PG8_SA(1, 1), a1 + hA, voffA);
            PG8_WAIT_V(8); PG8_WAIT_L(0); PG8_BAR; PG8_MMA(0, 0, At, B0); PG8_MMA(0, 1, At, B1); PG8_BAR; PG8_SCHED;
            PG8_LDA(At, 0, 1); PG8_STAGE(PG8_SB(0, 0), b2, voffB); PG8_STAGE(PG8_SB(0, 1), b2 + hB, voffB); PG8_STAGE(PG8_SA(0, 0), a2, voffA);
            PG8_WAIT_V(8); PG8_WAIT_L(0); PG8_BAR; PG8_MMA(1, 0, At, B0); PG8_MMA(1, 1, At, B1); PG8_BAR; PG8_SCHED;
            PG8_LDB(B0, 1, 0); PG8_LDB(B1, 1, 1); PG8_SCHED; PG8_LDA(At, 1, 0); PG8_STAGE(PG8_SA(0, 1), a2 + hA, voffA);
            PG8_WAIT_V(8); PG8_WAIT_L(0); PG8_BAR; PG8_MMA(0, 0, At, B0); PG8_MMA(0, 1, At, B1); PG8_BAR; PG8_SCHED;
            PG8_LDA(At, 1, 1); PG8_STAGE(PG8_SB(1, 0), b3, voffB); PG8_STAGE(PG8_SB(1, 1), b3 + hB, voffB); PG8_STAGE(PG8_SA(1, 0), a3, voffA);
            PG8_WAIT_V(8); PG8_WAIT_L(0); PG8_BAR; PG8_MMA(1, 0, At, B0); PG8_MMA(1, 1, At, B1); PG8_BAR; PG8_SCHED;
            } else {
            PG8_LDB(B0, 0, 0); PG8_SCHED; PG8_LDA(At, 0, 0); PG8_STAGE(PG8_SA(1, 1), a1 + hA, voffA);
            PG8_WAIT_L(8); PG8_BAR; PG8_WAIT_L(0); PG8_MMA(0, 0, At, B0); PG8_BAR; PG8_SCHED;
            PG8_LDB(B1, 0, 1); PG8_STAGE(PG8_SB(0, 0), b2, voffB);
            PG8_BAR; PG8_WAIT_L(0); PG8_MMA(0, 1, At, B1); PG8_BAR;
            PG8_LDA(At, 0, 1); PG8_STAGE(PG8_SA(0, 0), a2, voffA);
            PG8_BAR; PG8_WAIT_L(0); PG8_MMA(1, 0, At, B0); PG8_BAR; PG8_SCHED;
            PG8_STAGE(PG8_SB(0, 1), b2 + hB, voffB);
            PG8_WAIT_V(6); PG8_BAR; PG8_MMA(1, 1, At, B1); PG8_BAR;
            PG8_LDB(B0, 1, 0); PG8_SCHED; PG8_LDA(At, 1, 0); PG8_STAGE(PG8_SA(0, 1), a2 + hA, voffA);
            PG8_WAIT_L(8); PG8_BAR; PG8_WAIT_L(0); PG8_MMA(0, 0, At, B0); PG8_BAR; PG8_SCHED;
            PG8_LDB(B1, 1, 1); PG8_STAGE(PG8_SB(1, 0), b3, voffB);
            PG8_BAR; PG8_WAIT_L(0); PG8_MMA(0, 1, At, B1); PG8_BAR;
            PG8_LDA(At, 1, 1); PG8_STAGE(PG8_SA(1, 0), a3, voffA);
            PG8_BAR; PG8_WAIT_L(0); PG8_MMA(1, 0, At, B0); PG8_BAR; PG8_SCHED;
            PG8_STAGE(PG8_SB(1, 1), b3 + hB, voffB);
            PG8_WAIT_V(6); PG8_BAR; PG8_MMA(1, 1, At, B1); PG8_BAR;
            }
        }
        if constexpr (ALIGN_EPI) { if (wr == 0) PG8_BAR; }
        E(acc, cur, wr, wc, fr, fq);
        if (!has_next) break;
        if (!Epi::keep_acc(cur))
#pragma unroll
        for (int a = 0; a < 2; ++a)
#pragma unroll
            for (int b = 0; b < 2; ++b)
#pragma unroll
                for (int m = 0; m < 4; ++m)
#pragma unroll
                    for (int n = 0; n < 2; ++n) acc[a][b][m][n] = (f32x4){0.f, 0.f, 0.f, 0.f};
        cur = nxt; cA = nA; cB = nB; ++ui;
        if constexpr (ALIGN_EPI) { if (wr == 1) PG8_BAR; }
    }
    PG8_WAIT_V(0);
    if constexpr (!ALIGN_EPI) { if (wr == 0) PG8_BAR; }
    PG8_BAR;
#undef PG8_SA
#undef PG8_SB
#undef PG8_STAGE
#undef PG8_LDA
#undef PG8_LDB
#undef PG8_MMA
#undef PG8_WAIT_V
#undef PG8_WAIT_L
#undef PG8_BAR
#undef PG8_SCHED
}
}

namespace att {
constexpr int SHM_V = 16384, SHM_K = 16384;
constexpr int OFF_V = 0, OFF_K = 3 * SHM_V, OFF_WS = OFF_K + 3 * SHM_K, OFF_TBL = OFF_WS + 8 * 256 + 1024;
#define KSWZ(row, colB) ((row) * 256 + ((colB) ^ (((row) & 7) << 4)))
#define SBAR() __builtin_amdgcn_sched_barrier(0)
__device__ __forceinline__ int crow(int r, int hi) { return (r & 3) + 8 * (r >> 2) + 4 * hi; }
__device__ __forceinline__ int v_st(int k, int c) { const int kk = (k & ~0xC) | ((k & 4) << 1) | ((k & 8) >> 1); return ((kk >> 3) * 4 + (c >> 5)) * 512 + ((kk & 7) * 32 + (c & 31)) * 2; }
__device__ __forceinline__ int v_rd_base(int lane) { return ((lane & 3) << 3) | (((lane >> 2) & 3) << 6) | (((lane >> 4) & 1) << 5) | (((lane >> 5) & 1) << 8); }
constexpr int v_rd_off(int d0, int ks, int half) { return d0 * 512 + ks * 4096 + half * 2048; }
template <int OFF> __device__ __forceinline__ s16x4 tr_read(int vb) {
    s16x4 r; asm volatile("ds_read_b64_tr_b16 %0, %1 offset:%2" : "=&v"(r) : "v"(vb), "i"(OFF) : "memory"); return r;
}
#define PK(L, H) (bf16x8){L[0], L[1], L[2], L[3], H[0], H[1], H[2], H[3]}
struct VFrag { s16x4 l0, h0, l1, h1, l2, h2, l3, h3; };
template <int D0> __device__ __forceinline__ void pv_reads(VFrag& f, int vb) {
    f.l0 = tr_read<v_rd_off(D0, 0, 0)>(vb); f.h0 = tr_read<v_rd_off(D0, 0, 1)>(vb); f.l1 = tr_read<v_rd_off(D0, 1, 0)>(vb); f.h1 = tr_read<v_rd_off(D0, 1, 1)>(vb);
    f.l2 = tr_read<v_rd_off(D0, 2, 0)>(vb); f.h2 = tr_read<v_rd_off(D0, 2, 1)>(vb); f.l3 = tr_read<v_rd_off(D0, 3, 0)>(vb); f.h3 = tr_read<v_rd_off(D0, 3, 1)>(vb);
}
__device__ __forceinline__ void pv_mma(f32x16& od, const VFrag& f, bf16x8 pa0, bf16x8 pa1, bf16x8 pa2, bf16x8 pa3) {
    od = __builtin_amdgcn_mfma_f32_32x32x16_bf16(pa0, PK(f.l0, f.h0), od, 0, 0, 0);
    od = __builtin_amdgcn_mfma_f32_32x32x16_bf16(pa1, PK(f.l1, f.h1), od, 0, 0, 0);
    od = __builtin_amdgcn_mfma_f32_32x32x16_bf16(pa2, PK(f.l2, f.h2), od, 0, 0, 0);
    od = __builtin_amdgcn_mfma_f32_32x32x16_bf16(pa3, PK(f.l3, f.h3), od, 0, 0, 0);
}
__device__ __forceinline__ void pv_all(f32x16 (&o)[4], int vb, bf16x8 pa0, bf16x8 pa1, bf16x8 pa2, bf16x8 pa3) {
    VFrag fa, fb;
    pv_reads<0>(fa, vb); pv_reads<1>(fb, vb);
    asm volatile("s_waitcnt lgkmcnt(8)" ::: "memory"); SBAR(); pv_mma(o[0], fa, pa0, pa1, pa2, pa3); SBAR();
    pv_reads<2>(fa, vb);
    asm volatile("s_waitcnt lgkmcnt(8)" ::: "memory"); SBAR(); pv_mma(o[1], fb, pa0, pa1, pa2, pa3); SBAR();
    pv_reads<3>(fb, vb);
    asm volatile("s_waitcnt lgkmcnt(8)" ::: "memory"); SBAR(); pv_mma(o[2], fa, pa0, pa1, pa2, pa3); SBAR();
    asm volatile("s_waitcnt lgkmcnt(0)" ::: "memory"); SBAR(); pv_mma(o[3], fb, pa0, pa1, pa2, pa3);
}
#undef PK
template <bool ISB>
__device__ __forceinline__ void attn_unit(LAS unsigned char* lds, const bf16_t* __restrict__ QKVG, bf16_t* __restrict__ OAB, const float* __restrict__ sink, const float* __restrict__ rpb,
                                          int b, int hh, int blk) {
    int tid = threadIdx.x; asm volatile("" : "+v"(tid));
    const int wid = __builtin_amdgcn_readfirstlane(tid >> 6), lane = tid & 63, r32 = lane & 31, hi = lane >> 5;
    LAS unsigned char* V_lds = lds + OFF_V; LAS unsigned char* K_lds = lds + OFF_K;
    LAS float* wsc = (LAS float*)(lds + OFF_WS) + wid * 64;
    LAS float* tbl = (LAS float*)(lds + OFF_TBL);
    int qrow0, qcol, kcol, vcol, ocol, nt, lat0;
    int qoff = (wid & 1) * 32 + r32;
    int rq = 0, wlo = 0;
    if (ISB) {
        const int r0 = blk * 4; rq = r0 + (wid >> 1); wlo = min(max(rq - 4, 0), 120);
        const int kr0 = min(max(r0 - 4, 0), 120), kr1 = min(max(r0 + 3 - 4, 0), 120) + 8;
        lat0 = kr0; nt = 4 + (kr1 - kr0);
        qrow0 = b * SEQ + rq * 64 + (wid & 1) * 32; qcol = C_QB + hh * 128; kcol = C_KB + hh * 128; vcol = C_VB + hh * 128; ocol = 1024 + hh * 128;
    } else {
        const int t0 = blk * 64; const int jl0 = t0 >= 128 ? 0 : (128 - t0) / 64; const int jl1 = min(5, (SEQ + 128 - t0) / 64);
        lat0 = jl0; nt = 4 + (jl1 - jl0);
        const int head = hh * 4 + (wid >> 1);
        qrow0 = b * SEQ + t0 + (wid & 1) * 32; qcol = C_QA + head * 128; kcol = C_KA + hh * 128; vcol = C_VA + hh * 128; ocol = head * 128;
    }
    auto tile_row = [&](int i) -> int {
        if (i < 4) return MTOK + b * CTXL + 64 * i;
        if (ISB) return b * SEQ + (lat0 + i - 4) * 64;
        return b * SEQ + blk * 64 - 128 + 64 * (lat0 + i - 4);
    };
    bf16x8 qr[8];
    { const bf16_t* Qw = QKVG + (size_t)(qrow0 + r32) * DIN + qcol + hi * 8;
#pragma unroll
      for (int d0 = 0; d0 < 8; ++d0) qr[d0] = *(const bf16x8*)(Qw + d0 * 16); }
    float m_reg, l_reg;
    if (ISB) { m_reg = NEGBIG; l_reg = 0.f; for (int i = tid; i < 465; i += 512) tbl[i] = rpb[hh * 465 + i] * LOG2E; }
    else { m_reg = sink[hh * 4 + (wid >> 1)] * LOG2E; l_reg = 1.f; }
    f32x16 o[4];
#pragma unroll
    for (int d = 0; d < 4; ++d)
#pragma unroll
        for (int r = 0; r < 16; ++r) o[d][r] = 0.f;
    const int vb0 = (int)(uintptr_t)V_lds + v_rd_base(lane);
    unsigned koff[2], voff[2];
#pragma unroll
    for (int i = 0; i < 2; ++i) { const int g = (i * 8 + wid) * 64 + lane;
        { const int row = g >> 4, c = (g & 15) ^ (row & 7); koff[i] = (unsigned)(row * DIN + c * 8) * 2u; }
        { const int sub = g >> 5, kk = (sub >> 2) * 8 + ((g >> 2) & 7), c = (sub & 3) * 32 + (g & 3) * 8, k = (kk & ~0xC) | ((kk & 4) << 1) | ((kk & 8) >> 1); voff[i] = (unsigned)(k * DIN + c) * 2u; } }
    const unsigned ldsw = (unsigned)wid * 1024u;
    const int kb0 = r32 * 256 + (((0 + hi) ^ (r32 & 7)) << 4), kb1 = r32 * 256 + (((2 + hi) ^ (r32 & 7)) << 4), kb2 = r32 * 256 + (((4 + hi) ^ (r32 & 7)) << 4), kb3 = r32 * 256 + (((6 + hi) ^ (r32 & 7)) << 4);
#define SSTAGE(R0, bb) do { const char* gk_ = (const char*)(QKVG + (size_t)(R0) * DIN + kcol); const char* gv_ = (const char*)(QKVG + (size_t)(R0) * DIN + vcol); \
        _Pragma("unroll") for (int _i = 0; _i < 2; ++_i) { \
            __builtin_amdgcn_global_load_lds((const unsigned*)(gk_ + koff[_i]), (LAS unsigned*)(K_lds + (bb) * SHM_K + ldsw + _i * 8192), 16, 0, 0); \
            __builtin_amdgcn_global_load_lds((const unsigned*)(gv_ + voff[_i]), (LAS unsigned*)(V_lds + (bb) * SHM_V + ldsw + _i * 8192), 16, 0, 0); } } while (0)
#define PK4(P, BASE, OUT) do { unsigned a0 = cvt_pk_bf16(P[BASE + 0], P[BASE + 1]), a1 = cvt_pk_bf16(P[BASE + 2], P[BASE + 3]);   \
    unsigned b0 = cvt_pk_bf16(P[BASE + 4], P[BASE + 5]), b1 = cvt_pk_bf16(P[BASE + 6], P[BASE + 7]);                              \
    auto r0 = __builtin_amdgcn_permlane32_swap(a0, b0, false, false); auto r1 = __builtin_amdgcn_permlane32_swap(a1, b1, false, false); \
    u32x4 w = {r0[0], r1[0], r0[1], r1[1]}; OUT = *reinterpret_cast<bf16x8*>(&w); } while (0)
#define ATT_FINISH(VS) do { \
        float pmax = p0[0]; \
        _Pragma("unroll") for (int r = 1; r < 16; ++r) pmax = fmaxf(pmax, p0[r]); \
        _Pragma("unroll") for (int r = 0; r < 16; ++r) pmax = fmaxf(pmax, p1[r]); \
        { auto rr = __builtin_amdgcn_permlane32_swap(__float_as_uint(pmax), __float_as_uint(pmax), false, false); \
          pmax = fmaxf(__uint_as_float(rr[0]), __uint_as_float(rr[1])); } \
        if (!__all(pmax - m_reg <= 8.0f)) { \
            const float mn = fmaxf(m_reg, pmax); const float alpha = __builtin_amdgcn_exp2f(m_reg - mn); m_reg = mn; l_reg *= alpha; \
            if (hi == 0) wsc[r32] = alpha; asm volatile("s_waitcnt lgkmcnt(0)" ::: "memory"); \
            _Pragma("unroll") for (int r = 0; r < 16; ++r) { const float al = wsc[crow(r, hi)]; \
                _Pragma("unroll") for (int d = 0; d < 4; ++d) o[d][r] *= al; } \
            asm volatile("s_waitcnt lgkmcnt(0)" ::: "memory"); } \
        float ps = 0.f; \
        _Pragma("unroll") for (int r = 0; r < 16; ++r) { p0[r] = __builtin_amdgcn_exp2f(p0[r] - m_reg); ps += p0[r]; } \
        _Pragma("unroll") for (int r = 0; r < 16; ++r) { p1[r] = __builtin_amdgcn_exp2f(p1[r] - m_reg); ps += p1[r]; } \
        { auto rr = __builtin_amdgcn_permlane32_swap(__float_as_uint(ps), __float_as_uint(ps), false, false); \
          ps = __uint_as_float(rr[0]) + __uint_as_float(rr[1]); } \
        l_reg += ps; \
        bf16x8 pa0, pa1, pa2, pa3; \
        PK4(p0, 0, pa0); PK4(p0, 8, pa1); PK4(p1, 0, pa2); PK4(p1, 8, pa3); \
        pv_all(o, vb0 + (VS) * SHM_V, pa0, pa1, pa2, pa3); } while (0)
    SSTAGE(tile_row(0), 0); asm volatile("s_waitcnt vmcnt(0) lgkmcnt(0)" ::: "memory"); __builtin_amdgcn_s_barrier(); asm volatile("" ::: "memory");
    const bool late = wid >= 4; bool pending = false; int bprev = 0;
    f32x16 p0, p1;
#pragma unroll
    for (int r = 0; r < 16; ++r) { p0[r] = 0.f; p1[r] = 0.f; }
    int bb = 0, bn = 1;
    for (int i = 0; i < nt; ++i) {
        if (i + 1 < nt) SSTAGE(tile_row(i + 1), bn);
        if (late && pending) { ATT_FINISH(bprev); pending = false; }
        bool active = true; int dr = 0, mmode = 0;
        if (ISB) { if (i >= 4) { const int kr = lat0 + i - 4; active = (kr >= wlo) && (kr < wlo + 8); dr = kr - rq + 7; } }
        else { if (i >= 4) { const int jl = lat0 + i - 4; mmode = jl == 0 ? 1 : (jl == 4 ? 2 : 0); } }
        if (active) {
#pragma unroll
            for (int r = 0; r < 16; ++r) { p0[r] = 0.f; p1[r] = 0.f; }
            const LAS unsigned char* Ks = K_lds + bb * SHM_K;
#define KADDR(d0) (Ks + (((d0) & 3) == 0 ? kb0 : ((d0) & 3) == 1 ? kb1 : ((d0) & 3) == 2 ? kb2 : kb3) + ((d0) >> 2) * 128)
#define LOADG(F, g) do { F[0] = *(const LAS bf16x8*)(KADDR(2 * (g))); F[1] = *(const LAS bf16x8*)(KADDR(2 * (g)) + 8192); F[2] = *(const LAS bf16x8*)(KADDR(2 * (g) + 1)); F[3] = *(const LAS bf16x8*)(KADDR(2 * (g) + 1) + 8192); } while (0)
#define MMAG(F, g) do { p0 = __builtin_amdgcn_mfma_f32_32x32x16_bf16(F[0], qr[2 * (g)], p0, 0, 0, 0); p1 = __builtin_amdgcn_mfma_f32_32x32x16_bf16(F[1], qr[2 * (g)], p1, 0, 0, 0); \
                p0 = __builtin_amdgcn_mfma_f32_32x32x16_bf16(F[2], qr[2 * (g) + 1], p0, 0, 0, 0); p1 = __builtin_amdgcn_mfma_f32_32x32x16_bf16(F[3], qr[2 * (g) + 1], p1, 0, 0, 0); } while (0)
            { bf16x8 fa[4], fb[4];
              LOADG(fa, 0); LOADG(fb, 1); SBAR();
              MMAG(fa, 0); SBAR(); LOADG(fa, 2); SBAR();
              MMAG(fb, 1); SBAR(); LOADG(fb, 3); SBAR();
              MMAG(fa, 2); SBAR();
              MMAG(fb, 3); SBAR(); }
#undef KADDR
#undef LOADG
#undef MMAG
            int hi4 = 4 * hi; asm volatile("" : "+v"(hi4));
            if (ISB) {
                if (i >= 4) { int qo_ = qoff; asm volatile("" : "+v"(qo_)); const int cs = min(max(qo_ - 8, 0), 48); const LAS float* tb = tbl + dr * 31 + 15 - qo_;
#pragma unroll
                    for (int r = 0; r < 16; ++r) { const int c0 = crow(r, 0) + hi4, c1 = 32 + c0;
                        const float b0 = tb[c0], b1 = tb[c1];
                        p0[r] = ((unsigned)(c0 - cs) < 16u) ? p0[r] + b0 : NEGBIG;
                        p1[r] = ((unsigned)(c1 - cs) < 16u) ? p1[r] + b1 : NEGBIG; } }
            } else {
                int qo_ = qoff; asm volatile("" : "+v"(qo_));
                if (mmode == 1) {
#pragma unroll
                    for (int r = 0; r < 16; ++r) { const int c0 = crow(r, 0) + hi4, c1 = 32 + c0; p0[r] = c0 >= qo_ ? p0[r] : NEGBIG; p1[r] = c1 >= qo_ ? p1[r] : NEGBIG; } }
                else if (mmode == 2) {
#pragma unroll
                    for (int r = 0; r < 16; ++r) { const int c0 = crow(r, 0) + hi4, c1 = 32 + c0; p0[r] = c0 <= qo_ ? p0[r] : NEGBIG; p1[r] = c1 <= qo_ ? p1[r] : NEGBIG; } }
            }
            if (!late) { ATT_FINISH(bb); } else { pending = true; bprev = bb; }
        }
        asm volatile("s_waitcnt vmcnt(0) lgkmcnt(0)" ::: "memory");
        __builtin_amdgcn_s_barrier(); asm volatile("" ::: "memory");
        bb = bb == 2 ? 0 : bb + 1; bn = bn == 2 ? 0 : bn + 1;
    }
    if (late && pending) { ATT_FINISH(bprev); }
#undef ATT_FINISH
#undef PK4
#undef SSTAGE
    if (hi == 0) wsc[r32] = l_reg; asm volatile("s_waitcnt lgkmcnt(0)" ::: "memory");
    bf16_t* Ow = OAB + (size_t)qrow0 * DM + ocol;
#pragma unroll
    for (int r = 0; r < 16; ++r) { const int orow = crow(r, hi); const float rl = __builtin_amdgcn_rcpf(wsc[orow]);
#pragma unroll
        for (int d0 = 0; d0 < 4; ++d0) { const unsigned w = cvt_pk_bf16(o[d0][r] * rl, 0.f); Ow[(size_t)orow * DM + d0 * 32 + r32] = (bf16_t)(w & 0xffffu); } }
    asm volatile("s_waitcnt lgkmcnt(0)" ::: "memory");
    __syncthreads();
}
}

template <int MODE> __device__ __forceinline__ int dest_row(int o) {
    if (MODE == 1) { if (o >= C_VA) return o; const int base = o & ~63, w = o & 63; return base + (w < 32 ? 8 * (w >> 2) + (w & 3) : 8 * ((w - 32) >> 2) + 4 + (w & 3)); }
    if (MODE == 2) { if (o < DFF) return 256 * (o >> 7) + (o & 127); const int q = o - DFF; return 256 * (q >> 7) + 128 + (q & 127); }
    return o;
}
template <int MODE> __device__ __forceinline__ void p0_transpose_item(const float* __restrict__ W, int K, int N, bf16_t* __restrict__ WT, LAS float* scr, int item, int lane) {
    const int nblk = N / 32, kb = item / nblk, nb = item % nblk, k0 = 64 * kb, n0 = 32 * nb;
    float tv[32];
#pragma unroll
    for (int i = 0; i < 32; ++i) { const int kk = 2 * i + (lane >> 5); tv[i] = __builtin_nontemporal_load(W + (size_t)(k0 + kk) * N + n0 + (lane & 31)); }
#pragma unroll
    for (int i = 0; i < 32; ++i) { const int kk = 2 * i + (lane >> 5); scr[kk * 33 + (lane & 31)] = tv[i]; }
    asm volatile("s_waitcnt lgkmcnt(0)" ::: "memory");
    const int c = lane & 7;
#pragma unroll
    for (int j = 0; j < 4; ++j) { const int n = (lane >> 3) + 8 * j; const LAS float* s = scr + (8 * c) * 33 + n;
        u32x4 o; o.x = cvt_pk_bf16(s[0 * 33], s[1 * 33]); o.y = cvt_pk_bf16(s[2 * 33], s[3 * 33]); o.z = cvt_pk_bf16(s[4 * 33], s[5 * 33]); o.w = cvt_pk_bf16(s[6 * 33], s[7 * 33]);
        *(u32x4*)(WT + (size_t)dest_row<MODE>(n0 + n) * K + k0 + 8 * c) = o; }
    asm volatile("s_waitcnt lgkmcnt(0)" ::: "memory");
}

struct Args { const float* in[20]; float* out; unsigned char* ws; int ph_lo, ph_hi; };
enum { I_X = 0, I_C, I_CTX, I_CCTX, I_WMOD, I_BMOD, I_GAPRE, I_GAPOST, I_GFPRE, I_GFPOST, I_WIN, I_SINK, I_RPB, I_WBA, I_WBB, I_WO, I_WUP, I_CONVW, I_CONVB, I_WDN };
constexpr int NPHASE = 11;

__global__ void __launch_bounds__(512, 2) fwd_mega(Args args) {
    extern __shared__ __attribute__((aligned(16))) unsigned char lds_raw[];
    LAS unsigned char* lds = (LAS unsigned char*)lds_raw;
    cg::grid_group grid = cg::this_grid();
    const int tid = threadIdx.x, lane = tid & 63, wave = __builtin_amdgcn_readfirstlane(tid >> 6);
    const int G = gridDim.x, bid = blockIdx.x;
    const int gw = bid * 8 + wave, NGW = G * 8;
    unsigned char* ws = args.ws;
    float* MOD = (float*)(ws + WS_MOD); float* ROPEC = (float*)(ws + WS_ROPEC); float* ROPES = (float*)(ws + WS_ROPES);
    bf16_t* WIN = (bf16_t*)(ws + WS_WIN); bf16_t* WBA = (bf16_t*)(ws + WS_WBA); bf16_t* WBB = (bf16_t*)(ws + WS_WBB); bf16_t* WO = (bf16_t*)(ws + WS_WO);
    bf16_t* WUP = (bf16_t*)(ws + WS_WUP); bf16_t* WDN = (bf16_t*)(ws + WS_WDN);
    bf16_t* H = (bf16_t*)(ws + WS_H); bf16_t* Z = H; bf16_t* F = H;
    bf16_t* OAB = (bf16_t*)(ws + WS_OAB); bf16_t* H2 = OAB;
    bf16_t* QKVG = (bf16_t*)(ws + WS_QKVG); bf16_t* Y = (bf16_t*)(ws + WS_Y); bf16_t* ACT = (bf16_t*)(ws + WS_ACT); bf16_t* HALO = (bf16_t*)(ws + WS_HALO);
    const int lo = args.ph_lo, hi_ph = args.ph_hi;
    volatile LAS unsigned* MISC = (volatile LAS unsigned*)(lds + 131072 + 320);
    if (tid < 32) MISC[tid] = 0u;
    __syncthreads();
    XcdBarrier xbar = xcd_barrier_post((unsigned*)(ws + WS_BAR), MISC + 8);
#ifndef REPMASK
#define REPMASK 0
#endif
#define NREP(k) ((((REPMASK) >> (k)) & 1) ? 2 : 1)
#define IN(k) (lo <= (k) && (k) < hi_ph)
#define SEAM(k) do { if (IN(k) && IN((k) + 1)) xcd_barrier(xbar); } while (0)
    if (args.ph_lo > NPHASE) grid.sync();

    for (int rep_ = 0; rep_ < NREP(0); ++rep_) if (IN(0)) {
        int tid = threadIdx.x; asm volatile("" : "+v"(tid)); const int lane = tid & 63; (void)lane;
        LAS float* sl = (LAS float*)lds;
        LAS float* red = sl + 5 * DM;
        const float* c = args.in[I_C]; const float* cctx = args.in[I_CCTX];
        for (int i = tid; i < 5 * DM; i += 512) { const int b = i / DM, k = i % DM; const float v = b < 4 ? c[b * DM + k] : cctx[k]; sl[i] = v / (1.0f + __expf(-v)); }
        __syncthreads();
        const float* wmod = args.in[I_WMOD]; const float* bmod = args.in[I_BMOD];
        for (int item = bid; item < NMOD / 32; item += G) {
            const int n0 = item * 32, cn = tid & 31, kg = tid >> 5;
            float a0 = 0.f, a1 = 0.f, a2 = 0.f, a3 = 0.f, a4 = 0.f;
            const float* wp = wmod + (size_t)(kg * 128) * NMOD + n0 + cn; const LAS float* sp = sl + kg * 128;
#pragma unroll 32
            for (int kk = 0; kk < 128; ++kk) { const float w = __builtin_nontemporal_load(wp + (size_t)kk * NMOD);
                a0 += sp[kk] * w; a1 += sp[DM + kk] * w; a2 += sp[2 * DM + kk] * w; a3 += sp[3 * DM + kk] * w; a4 += sp[4 * DM + kk] * w; }
            LAS float* rp = red + (kg * 32 + cn) * 5; rp[0] = a0; rp[1] = a1; rp[2] = a2; rp[3] = a3; rp[4] = a4;
            __syncthreads();
            if (tid < 160) { const int b = tid >> 5, cn2 = tid & 31; float s = 0.f;
#pragma unroll
                for (int q = 0; q < 16; ++q) s += red[(q * 32 + cn2) * 5 + b];
                MOD[b * NMOD + n0 + cn2] = s + bmod[n0 + cn2]; }
            __syncthreads();
        }
        for (int i = bid * 512 + tid; i < 128 * 32; i += G * 512) { const int pos = i >> 5, j = i & 31;
            const float inv = powf(10000.0f, -(float)j / 32.0f); const float ang = (float)pos * inv; ROPEC[i] = cosf(ang); ROPES[i] = sinf(ang); }
        __syncthreads();
        LAS float* scr = (LAS float*)(lds + wave * 16384);
        constexpr int I_IN = (DM / 64) * (DIN / 32), I_BR = (1024 / 64) * (DM / 32), I_O = (DM / 64) * (DM / 32), I_UP = (DM / 64) * (DUP / 32), I_DN = (DFF / 64) * (DM / 32);
        constexpr int NITEMS = I_IN + 2 * I_BR + I_O + I_UP + I_DN;
        for (int it = gw; it < NITEMS; it += NGW) {
            int r = it;
            if (r < I_IN) { p0_transpose_item<1>(args.in[I_WIN], DM, DIN, WIN, scr, r, lane); continue; } r -= I_IN;
            if (r < I_BR) { p0_transpose_item<0>(args.in[I_WBA], 1024, DM, WBA, scr, r, lane); continue; } r -= I_BR;
            if (r < I_BR) { p0_transpose_item<0>(args.in[I_WBB], 1024, DM, WBB, scr, r, lane); continue; } r -= I_BR;
            if (r < I_O) { p0_transpose_item<0>(args.in[I_WO], DM, DM, WO, scr, r, lane); continue; } r -= I_O;
            if (r < I_UP) { p0_transpose_item<2>(args.in[I_WUP], DM, DUP, WUP, scr, r, lane); continue; } r -= I_UP;
            p0_transpose_item<0>(args.in[I_WDN], DFF, DM, WDN, scr, r, lane);
        }
        __syncthreads();
    }
    SEAM(0);

    for (int rep_ = 0; rep_ < NREP(1); ++rep_) if (IN(1)) {
        int tid = threadIdx.x; asm volatile("" : "+v"(tid)); const int lane = tid & 63; (void)lane;
        const float* x = args.in[I_X]; const float* ctx = args.in[I_CTX]; const float* g = args.in[I_GAPRE];
#define P1_LOAD(V, R) do { const f32x4* xr_ = (const f32x4*)(srcb + (size_t)(R) * DM) + lane; \
        _Pragma("unroll") for (int j = 0; j < 8; ++j) V[j] = __builtin_nontemporal_load(xr_ + 64 * j); } while (0)
#define P1_PROC(V, R) do { float ss_ = 0.f; \
        _Pragma("unroll") for (int j = 0; j < 8; ++j) ss_ += (V[j].x * V[j].x + V[j].y * V[j].y) + (V[j].z * V[j].z + V[j].w * V[j].w); \
        const float rstd_ = 1.0f / sqrtf(wave_sum(ss_) * (1.0f / DM) + EPS); u32x2* hr_ = (u32x2*)(H + (row0 + (size_t)(R)) * DM) + lane; \
        _Pragma("unroll") for (int j = 0; j < 8; ++j) { const f32x4 hv = (V[j] * rstd_) * PA[j] + PB[j]; \
            u32x2 w; w.x = cvt_pk_bf16(hv.x, hv.y); w.y = cvt_pk_bf16(hv.z, hv.w); hr_[64 * j] = w; } } while (0)
        for (int b = 0; b < 5; ++b) {
            const int nrows = b < 4 ? SEQ : MCTX; const size_t row0 = b < 4 ? (size_t)b * SEQ : (size_t)MTOK;
            const float* srcb = b < 4 ? x + (size_t)b * SEQ * DM : ctx; const float* mb = MOD + b * NMOD;
            f32x4 PA[8], PB[8];
#pragma unroll
            for (int j = 0; j < 8; ++j) { const int col = 4 * (lane + 64 * j); PA[j] = *(const f32x4*)(g + col) * (*(const f32x4*)(mb + DM + col) + 1.0f); PB[j] = *(const f32x4*)(mb + col); }
            f32x4 va[8], vb[8]; int r = gw;
            if (r < nrows) P1_LOAD(va, r);
            for (; r < nrows; r += 2 * NGW) {
                const int r2 = r + NGW, r3 = r2 + NGW;
                if (r2 < nrows) P1_LOAD(vb, r2);
                P1_PROC(va, r);
                if (r3 < nrows) P1_LOAD(va, r3);
                if (r2 < nrows) P1_PROC(vb, r2);
            }
        }
#undef P1_LOAD
#undef P1_PROC
    }
    SEAM(1);

    for (int rep_ = 0; rep_ < NREP(2); ++rep_) if (IN(2)) {
        pg8::Gemm g{H, WIN, DM, DM, DM, H, WIN}; pg8::Order S; S.init(MTOK / 256, DIN / 256, G, bid, 40);
        pg8::EpiQKV E{QKVG, ROPEC, ROPES};
        pg8::gemm_phase<pg8::EpiQKV, pg8::Order, false, true>(lds, g, S, E);
    }
    SEAM(2);

    for (int rep_ = 0; rep_ < NREP(3); ++rep_) if (IN(3)) {
        const float* sink = args.in[I_SINK]; const float* rpb = args.in[I_RPB];
#ifndef ATT_REP
#define ATT_REP 1
#endif
        const int vcu = (G % 8 == 0) ? (bid & 7) * (G >> 3) + (bid >> 3) : bid;
        for (int i0 = 0; i0 * G + vcu < 2048 * ATT_REP; ++i0) { const int i = i0 & 7;
            const int idx = (i >> 1) * G + vcu;
            if (idx >= 1024) continue;
            if (i & 1) { const int b = idx >> 8, h = (idx >> 5) & 7, rb = idx & 31; att::attn_unit<true>(lds, QKVG, OAB, sink, rpb, b, h, rb); }
            else { const int b = idx >> 8, kvh = (idx >> 7) & 1, blk = idx & 127; att::attn_unit<false>(lds, QKVG, OAB, sink, rpb, b, kvh, blk); }
        }
    }
    SEAM(3);

    for (int rep_ = 0; rep_ < NREP(4); ++rep_) if (IN(4)) {
        pg8::Gemm g{OAB, WBA, DM, 1024, 1024, OAB + 1024, WBB}; pg8::Order S; S.init(MTOK / 256, DM / 256, G, bid, 0, 1);
        pg8::EpiBranch2 E{Z, QKVG + C_GA, QKVG + C_GB};
        pg8::gemm_phase<pg8::EpiBranch2, pg8::Order, false, true>(lds, g, S, E);
    }
    SEAM(4);

    for (int rep_ = 0; rep_ < NREP(5); ++rep_) if (IN(5)) {
        pg8::Gemm g{Z, WO, DM, DM, DM, Z, WO}; pg8::Order S; S.init(MTOK / 256, DM / 256, G, bid, 0);
        pg8::EpiBf16 E{Y, DM};
        pg8::gemm_phase<pg8::EpiBf16, pg8::Order, false, true>(lds, g, S, E);
    }
    SEAM(5);

    for (int rep_ = 0; rep_ < NREP(6); ++rep_) if (IN(6)) {
        int tid = threadIdx.x; asm volatile("" : "+v"(tid)); const int lane = tid & 63; (void)lane;
        const float* x = args.in[I_X]; const float* gpost = args.in[I_GAPOST]; const float* gpre = args.in[I_GFPRE];
#define P6_LOAD(VX, VY, M) do { const f32x4* xr_ = (const f32x4*)(x + (size_t)(M) * DM) + lane; const u32x2* yr_ = (const u32x2*)(Y + (size_t)(M) * DM) + lane; \
        _Pragma("unroll") for (int j = 0; j < 8; ++j) VY[j] = yr_[64 * j]; \
        _Pragma("unroll") for (int j = 0; j < 8; ++j) VX[j] = __builtin_nontemporal_load(xr_ + 64 * j); } while (0)
#define P6_PROC(VX, VY, M) do { float ss_ = 0.f; \
        _Pragma("unroll") for (int j = 0; j < 8; ++j) { const float y0 = bf_lo(VY[j].x), y1 = bf_hi(VY[j].x), y2 = bf_lo(VY[j].y), y3 = bf_hi(VY[j].y); ss_ += (y0 * y0 + y1 * y1) + (y2 * y2 + y3 * y3); } \
        const float rstd_ = 1.0f / sqrtf(wave_sum(ss_) * (1.0f / DM) + EPS); float s2_ = 0.f; \
        _Pragma("unroll") for (int j = 0; j < 8; ++j) { \
            const f32x4 yv = {bf_lo(VY[j].x), bf_hi(VY[j].x), bf_lo(VY[j].y), bf_hi(VY[j].y)}; \
            VX[j] = VX[j] + A1[j] * (yv * rstd_); \
            s2_ += (VX[j].x * VX[j].x + VX[j].y * VX[j].y) + (VX[j].z * VX[j].z + VX[j].w * VX[j].w); } \
        const float rstd2_ = 1.0f / sqrtf(wave_sum(s2_) * (1.0f / DM) + EPS); u32x2* hr_ = (u32x2*)(H2 + (size_t)(M) * DM) + lane; \
        _Pragma("unroll") for (int j = 0; j < 8; ++j) { const f32x4 hv = (VX[j] * rstd2_) * A2[j] + B2[j]; \
            u32x2 w; w.x = cvt_pk_bf16(hv.x, hv.y); w.y = cvt_pk_bf16(hv.z, hv.w); hr_[64 * j] = w; } } while (0)
        for (int b = 0; b < NBATCH; ++b) {
            const float* mb = MOD + b * NMOD; const int mend = (b + 1) * SEQ;
            f32x4 A1[8], A2[8], B2[8];
#pragma unroll
            for (int j = 0; j < 8; ++j) { const int col = 4 * (lane + 64 * j);
                A1[j] = *(const f32x4*)(mb + 2 * DM + col) * *(const f32x4*)(gpost + col);
                A2[j] = *(const f32x4*)(gpre + col) * (*(const f32x4*)(mb + 4 * DM + col) + 1.0f); B2[j] = *(const f32x4*)(mb + 3 * DM + col); }
            f32x4 xa[8]; u32x2 ya[8];
            for (int m = b * SEQ + gw; m < mend; m += NGW) { P6_LOAD(xa, ya, m); P6_PROC(xa, ya, m); }
        }
#undef P6_LOAD
#undef P6_PROC
    }
    SEAM(6);

    for (int rep_ = 0; rep_ < NREP(7); ++rep_) if (IN(7)) {
        pg8::Gemm g{H2, WUP, DM, DM, DM, H2, WUP}; pg8::Order S; S.init(MTOK / 256, DUP / 256, G, bid, 0);
        pg8::EpiUp E{ACT, HALO, args.in[I_CONVW], args.in[I_CONVB]};
        pg8::gemm_phase<pg8::EpiUp, pg8::Order, false, true>(lds, g, S, E);
    }
    SEAM(7);

    for (int rep_ = 0; rep_ < NREP(8); ++rep_) if (IN(8)) {
        int tid = threadIdx.x; asm volatile("" : "+v"(tid)); const int lane = tid & 63; (void)lane;
        const float* cw = args.in[I_CONVW]; const float* cb = args.in[I_CONVB];
        constexpr int NC8 = DFF / 8;
        const int total = 512 * 2 * NC8;
        for (int it = bid * 512 + tid; it < total; it += G * 512) {
            const int cg8 = it % NC8, rs = it / NC8, side = rs & 1, k = rs >> 1;
            const int c0 = cg8 * 8, dcol = 256 * (c0 >> 7) + (c0 & 127);
            const bf16_t* hk = HALO + (size_t)k * 4 * DUP;
            u32x4 ma, mg, za, zg, pa, pg; const u32x4 zero = {0u, 0u, 0u, 0u};
            if (side == 0) {
                if ((k & 127) == 0) { ma = zero; mg = zero; } else { const bf16_t* hm = hk - 4 * DUP + 3 * DUP; ma = *(const u32x4*)(hm + dcol); mg = *(const u32x4*)(hm + dcol + 128); }
                za = *(const u32x4*)(hk + dcol); zg = *(const u32x4*)(hk + dcol + 128);
                pa = *(const u32x4*)(hk + DUP + dcol); pg = *(const u32x4*)(hk + DUP + dcol + 128);
            } else {
                ma = *(const u32x4*)(hk + 2 * DUP + dcol); mg = *(const u32x4*)(hk + 2 * DUP + dcol + 128);
                za = *(const u32x4*)(hk + 3 * DUP + dcol); zg = *(const u32x4*)(hk + 3 * DUP + dcol + 128);
                if ((k & 127) == 127) { pa = zero; pg = zero; } else { const bf16_t* hn = hk + 4 * DUP; pa = *(const u32x4*)(hn + dcol); pg = *(const u32x4*)(hn + dcol + 128); }
            }
            float res[8];
#pragma unroll
            for (int e = 0; e < 8; ++e) {
                const unsigned wm_a = ma[e >> 1], wz_a = za[e >> 1], wp_a = pa[e >> 1], wm_g = mg[e >> 1], wz_g = zg[e >> 1], wp_g = pg[e >> 1];
                const float am = (e & 1) ? bf_hi(wm_a) : bf_lo(wm_a), az = (e & 1) ? bf_hi(wz_a) : bf_lo(wz_a), ap = (e & 1) ? bf_hi(wp_a) : bf_lo(wp_a);
                const float gm = (e & 1) ? bf_hi(wm_g) : bf_lo(wm_g), gz = (e & 1) ? bf_hi(wz_g) : bf_lo(wz_g), gp = (e & 1) ? bf_hi(wp_g) : bf_lo(wp_g);
                const int ca = c0 + e, cgc = DFF + c0 + e;
                const float va = cb[ca] + cw[ca] * am + cw[DUP + ca] * az + cw[2 * DUP + ca] * ap;
                const float vg = cb[cgc] + cw[cgc] * gm + cw[DUP + cgc] * gz + cw[2 * DUP + cgc] * gp;
                res[e] = va * vg * sigmoidf_(vg);
            }
            u32x4 w; w.x = cvt_pk_bf16(res[0], res[1]); w.y = cvt_pk_bf16(res[2], res[3]); w.z = cvt_pk_bf16(res[4], res[5]); w.w = cvt_pk_bf16(res[6], res[7]);
            const int row = k * 64 + (side ? 63 : 0);
            *(u32x4*)(ACT + (size_t)row * DFF + c0) = w;
        }
    }
    SEAM(8);

    for (int rep_ = 0; rep_ < NREP(9); ++rep_) if (IN(9)) {
        pg8::Gemm g{ACT, WDN, DFF, DFF, DFF, ACT, WDN}; pg8::Order S; S.init(MTOK / 256, DM / 256, G, bid, 0);
        pg8::EpiBf16 E{F, DM};
        pg8::gemm_phase<pg8::EpiBf16, pg8::Order, false, true>(lds, g, S, E);
    }
    SEAM(9);

    for (int rep_ = 0; rep_ < NREP(10); ++rep_) if (IN(10)) {
        int tid = threadIdx.x; asm volatile("" : "+v"(tid)); const int lane = tid & 63; (void)lane;
        const float* gpost = args.in[I_GFPOST]; const float* gpost1 = args.in[I_GAPOST]; const float* x = args.in[I_X];
#define PA_LOAD(VX, VY, VF, M) do { const f32x4* xr_ = (const f32x4*)(x + (size_t)(M) * DM) + lane; const u32x2* yr_ = (const u32x2*)(Y + (size_t)(M) * DM) + lane; const u32x2* fr_ = (const u32x2*)(F + (size_t)(M) * DM) + lane; \
        _Pragma("unroll") for (int j = 0; j < 8; ++j) VY[j] = yr_[64 * j]; \
        _Pragma("unroll") for (int j = 0; j < 8; ++j) VF[j] = fr_[64 * j]; \
        _Pragma("unroll") for (int j = 0; j < 8; ++j) VX[j] = __builtin_nontemporal_load(xr_ + 64 * j); } while (0)
#define PA_PROC(VX, VY, VF, M) do { float ss_ = 0.f, sy_ = 0.f; \
        _Pragma("unroll") for (int j = 0; j < 8; ++j) { const float y0 = bf_lo(VY[j].x), y1 = bf_hi(VY[j].x), y2 = bf_lo(VY[j].y), y3 = bf_hi(VY[j].y); sy_ += (y0 * y0 + y1 * y1) + (y2 * y2 + y3 * y3); } \
        _Pragma("unroll") for (int j = 0; j < 8; ++j) { const float y0 = bf_lo(VF[j].x), y1 = bf_hi(VF[j].x), y2 = bf_lo(VF[j].y), y3 = bf_hi(VF[j].y); ss_ += (y0 * y0 + y1 * y1) + (y2 * y2 + y3 * y3); } \
        const float rstdy_ = 1.0f / sqrtf(wave_sum(sy_) * (1.0f / DM) + EPS); \
        const float rstd_ = 1.0f / sqrtf(wave_sum(ss_) * (1.0f / DM) + EPS); \
        f32x4* orow_ = (f32x4*)(args.out + (size_t)(M) * DM) + lane; \
        _Pragma("unroll") for (int j = 0; j < 8; ++j) { \
            const f32x4 yv = {bf_lo(VY[j].x), bf_hi(VY[j].x), bf_lo(VY[j].y), bf_hi(VY[j].y)}; \
            const f32x4 fv = {bf_lo(VF[j].x), bf_hi(VF[j].x), bf_lo(VF[j].y), bf_hi(VF[j].y)}; \
            const f32x4 x1 = VX[j] + A1[j] * (yv * rstdy_); \
            __builtin_nontemporal_store(x1 + A3[j] * (fv * rstd_), orow_ + 64 * j); } } while (0)
        for (int b = 0; b < NBATCH; ++b) {
            const float* mb = MOD + b * NMOD; const int mend = (b + 1) * SEQ;
            f32x4 A1[8], A3[8];
#pragma unroll
            for (int j = 0; j < 8; ++j) { const int col = 4 * (lane + 64 * j);
                A1[j] = *(const f32x4*)(mb + 2 * DM + col) * *(const f32x4*)(gpost1 + col);
                A3[j] = *(const f32x4*)(mb + 5 * DM + col) * *(const f32x4*)(gpost + col); }
            f32x4 xa[8]; u32x2 ya[8], fa[8];
            for (int m = b * SEQ + gw; m < mend; m += NGW) { PA_LOAD(xa, ya, fa, m); PA_PROC(xa, ya, fa, m); }
        }
#undef PA_LOAD
#undef PA_PROC
    }
#undef IN
#undef SEAM
}

extern "C" void kernel_launch(void* const* d_in, const int* in_sizes, int n_in, void* d_out, int out_size, void* d_ws, size_t ws_size, hipStream_t stream) {
    static int grid = 0;
    if (grid == 0) {
        if (n_in != 20 || in_sizes[0] != MTOK * DM || out_size != MTOK * DM || ws_size < WS_END) {
            fprintf(stderr, "kernel_launch: unexpected shapes: n_in %d in0 %d out %d ws %zu (need >= %zu)\n", n_in, n_in > 0 ? in_sizes[0] : -1, out_size, ws_size, (size_t)WS_END); grid = -1; return; }
        int dev = 0, cus = 0, per_cu = 0;
        if (hipGetDevice(&dev) != hipSuccess || hipDeviceGetAttribute(&cus, hipDeviceAttributeMultiprocessorCount, dev) != hipSuccess) { fprintf(stderr, "kernel_launch: device query failed\n"); grid = -1; return; }
        if (hipFuncSetAttribute((const void*)fwd_mega, hipFuncAttributeMaxDynamicSharedMemorySize, LDS_BYTES) != hipSuccess) { fprintf(stderr, "kernel_launch: hipFuncSetAttribute failed\n"); grid = -1; return; }
        if (hipOccupancyMaxActiveBlocksPerMultiprocessor(&per_cu, (const void*)fwd_mega, 512, LDS_BYTES) != hipSuccess || per_cu < 1) { fprintf(stderr, "kernel_launch: occupancy query says %d\n", per_cu); per_cu = 1; }
        (void)hipGetLastError();
        grid = cus * 1;
        if (grid != 256) fprintf(stderr, "kernel_launch: note: %d CUs\n", cus);
    }
    if (grid < 0) return;
    if (hipMemsetAsync(d_ws, 0, CTL_ZERO_BYTES, stream) != hipSuccess) { fprintf(stderr, "kernel_launch: memset failed\n"); return; }
    Args a{};
    for (int i = 0; i < 20; ++i) a.in[i] = (const float*)d_in[i];
    a.out = (float*)d_out; a.ws = (unsigned char*)d_ws;
#if MK_N_LAUNCHES == 1
    a.ph_lo = 0; a.ph_hi = NPHASE;
    void* kargs[] = {&a};
    hipError_t e = hipLaunchCooperativeKernel((const void*)fwd_mega, dim3(grid), dim3(512), kargs, LDS_BYTES, stream);
    if (e != hipSuccess) fprintf(stderr, "kernel_launch: cooperative launch failed: %s (grid %d)\n", hipGetErrorString(e), grid);
#else
    for (int p = 0; p < NPHASE; ++p) { a.ph_lo = p; a.ph_hi = p + 1;
        hipLaunchKernelGGL(fwd_mega, dim3(grid), dim3(512), LDS_BYTES, stream, a);
        const hipError_t le = hipPeekAtLastError(); if (le != hipSuccess) { fprintf(stderr, "kernel_launch: launch %d failed: %s\n", p, hipGetErrorName(le)); break; } }
#endif
}
```

```cpp
#include <hip/hip_runtime.h>
#include <hip/hip_cooperative_groups.h>
#include <cstdio>
#include <cstdint>
namespace cg = cooperative_groups;

#ifndef MK_N_LAUNCHES
#define MK_N_LAUNCHES 1
#endif

#define LAS __attribute__((address_space(3)))
typedef unsigned short bf16_t;
typedef short bf16x8 __attribute__((ext_vector_type(8)));
typedef short s16x4 __attribute__((ext_vector_type(4)));
typedef float f32x4 __attribute__((ext_vector_type(4)));
typedef float f32x2 __attribute__((ext_vector_type(2)));
typedef float f32x16 __attribute__((ext_vector_type(16)));
typedef unsigned u32x4 __attribute__((ext_vector_type(4)));
typedef unsigned u32x2 __attribute__((ext_vector_type(2)));

constexpr int DM = 2048, NBATCH = 4, SEQ = 8192, CTXL = 256;
constexpr int MTOK = NBATCH * SEQ;
constexpr int MCTX = NBATCH * CTXL;
constexpr int MALL = MTOK + MCTX;
constexpr int DIN = 8704, DFF = 5632, DUP = 2 * DFF;
constexpr int C_QA = 0, C_KA = 1024, C_VA = 1280, C_QB = 1536, C_KB = 2560, C_VB = 3584, C_GA = 4608, C_GB = 6656;
constexpr int NMOD = 6 * DM;
constexpr float EPS = 1e-6f;
constexpr float LOG2E = 1.4426950408889634f;
constexpr float QSCALE = 0.08838834764831845f * LOG2E;
constexpr float NEGBIG = -1e30f;

constexpr size_t MiB = 1u << 20;
constexpr size_t WS_BAR = 16384, CTL_ZERO_BYTES = 64 * 1024;
constexpr size_t WS_MOD = 64 * 1024;
constexpr size_t WS_ROPEC = 512 * 1024;
constexpr size_t WS_ROPES = 768 * 1024;
constexpr size_t WS_WIN = 4 * MiB;
constexpr size_t WS_WBA = 38 * MiB;
constexpr size_t WS_WBB = 42 * MiB;
constexpr size_t WS_WO = 46 * MiB;
constexpr size_t WS_WUP = 54 * MiB;
constexpr size_t WS_WDN = 98 * MiB;
constexpr size_t WS_H = 120 * MiB;
constexpr size_t WS_OAB = 252 * MiB;
constexpr size_t WS_QKVG = 380 * MiB;
constexpr size_t WS_Y = 380 * MiB;
constexpr size_t WS_ACT = 508 * MiB;
constexpr size_t WS_HALO = 860 * MiB;
constexpr size_t WS_END = 941 * MiB;

constexpr int LDS_BYTES = 147456;

__device__ __forceinline__ unsigned cvt_pk_bf16(float lo, float hi) { unsigned r; asm volatile("v_cvt_pk_bf16_f32 %0, %1, %2" : "=v"(r) : "v"(lo), "v"(hi)); return r; }
__device__ __forceinline__ float bf_lo(unsigned w) { return __uint_as_float(w << 16); }
__device__ __forceinline__ float bf_hi(unsigned w) { return __uint_as_float(w & 0xffff0000u); }
__device__ __forceinline__ float wave_sum(float v) {
#pragma unroll
    for (int o = 1; o < 64; o <<= 1) v += __shfl_xor(v, o);
    return v;
}
__device__ __forceinline__ float sigmoidf_(float x) { return __builtin_amdgcn_rcpf(1.0f + __builtin_amdgcn_exp2f(-x * LOG2E)); }
template <int CTRL> __device__ __forceinline__ float dppf(float old, float src) {
    return __int_as_float(__builtin_amdgcn_update_dpp(__float_as_int(old), __float_as_int(src), CTRL, 0xf, 0xf, false));
}


#define XB_TMO      128
#define XB_XCNT(j)  (256  + 64 * (j))
#define XB_XSUB(j)  (1280 + 64 * (j))
#define XB_XGEN(j)  (2304 + 64 * (j))
#define XB_TOP      3328
#define XB_TOPGEN   3392
#define XCD_BAR_WORDS 3456
#define XB_SPIN_CAP (1u << 18)
__device__ __forceinline__ unsigned xb_ld(unsigned* p)              { return __hip_atomic_load(p, __ATOMIC_RELAXED, __HIP_MEMORY_SCOPE_AGENT); }
__device__ __forceinline__ unsigned xb_add(unsigned* p, unsigned v) { return __hip_atomic_fetch_add(p, v, __ATOMIC_RELAXED, __HIP_MEMORY_SCOPE_AGENT); }
__device__ __forceinline__ unsigned xb_xcc_id() { return (unsigned)__builtin_amdgcn_s_getreg((3 << 11) | 20) & 0xFu; }
#define XB_SPIN(cond, bar) do { unsigned _sp = 0; while (cond) { __builtin_amdgcn_s_sleep(1); \
    if ((++_sp & 255u) == 0u) { if (xb_ld(&(bar)[XB_TMO])) break; if (_sp > XB_SPIN_CAP) { atomicAdd(&(bar)[XB_TMO], 1u); break; } } } } while (0)
struct XcdBarrier { unsigned* bar; unsigned x; volatile LAS unsigned* st; };
__device__ __forceinline__ XcdBarrier xcd_barrier_post(unsigned* bar, volatile LAS unsigned* st) {
    XcdBarrier b; b.bar = bar; b.x = xb_xcc_id(); b.st = st;
    if (threadIdx.x == 0) (void)xb_add(&bar[XB_XCNT(b.x)], 1u);
    return b;
}
__device__ __forceinline__ void xcd_barrier_complete(unsigned* bar, unsigned x, unsigned& nloc, unsigned& nx) {
    const unsigned G = gridDim.x * gridDim.y * gridDim.z;
    unsigned sum, cnt, mine, sp = 0u;
    for (;;) {
        sum = 0u; cnt = 0u; mine = 0u;
#pragma unroll
        for (unsigned j = 0; j < 16; ++j) { const unsigned c = xb_ld(&bar[XB_XCNT(j)]); sum += c; cnt += (c > 0u) ? 1u : 0u; mine = (j == x) ? c : mine; }
        if (sum == G) break;
        __builtin_amdgcn_s_sleep(1);
        if ((++sp & 255u) == 0u) { if (xb_ld(&bar[XB_TMO])) break; if (sp > XB_SPIN_CAP) { atomicAdd(&bar[XB_TMO], 1u); break; } }
    }
    nloc = mine > 0u ? mine : 1u; nx = cnt > 0u ? cnt : 1u;
}
__device__ __forceinline__ void xcd_barrier(const XcdBarrier& b) {
    asm volatile("s_waitcnt vmcnt(0)" ::: "memory");
    __syncthreads();
    if (threadIdx.x == 0) {
        unsigned* bar = b.bar;
        __builtin_amdgcn_s_waitcnt(0);
        unsigned nloc = b.st[0], nx = b.st[1];
        if (nloc == 0u) { xcd_barrier_complete(bar, b.x, nloc, nx); b.st[0] = nloc; b.st[1] = nx; }
        const unsigned old = xb_add(&bar[XB_XSUB(b.x)], 1u);
        const unsigned gen = old / nloc;
        if (old + 1u == (gen + 1u) * nloc) {
            __builtin_amdgcn_fence(__ATOMIC_RELEASE, "agent");
            asm volatile("s_waitcnt vmcnt(0)" ::: "memory");
            const unsigned og = xb_add(&bar[XB_TOP], 1u);
            const unsigned tg = og / nx;
            if (og + 1u == (tg + 1u) * nx) xb_add(&bar[XB_TOPGEN], 1u);
            else XB_SPIN(xb_ld(&bar[XB_TOPGEN]) == tg, bar);
            __builtin_amdgcn_fence(__ATOMIC_ACQUIRE, "agent");
            xb_add(&bar[XB_XGEN(b.x)], 1u);
            asm volatile("s_waitcnt vmcnt(0)" ::: "memory");
        } else {
            XB_SPIN(xb_ld(&bar[XB_XGEN(b.x)]) == gen, bar);
            __builtin_amdgcn_fence(__ATOMIC_ACQUIRE, "agent");
            asm volatile("s_waitcnt vmcnt(0)" ::: "memory");
        }
    }
    __syncthreads();
}

namespace pg8 {
constexpr int BM = 256, BK = 64, HALF = 128, HTB = HALF * BK * 2, STAGE_BYTES = 8 * HTB, NXCD = 8, WGM = 8;
__host__ __device__ __forceinline__ int lds_byte(int r, int c) { const int st = (r >> 4) * 2 + (c >> 5), rr = r & 15, cc = c & 31, ob = rr * 64 + cc * 2; return st * 1024 + (ob ^ (((ob >> 9) & 1) << 5)); }
__host__ __device__ __forceinline__ void stage_rc(int b, int& R, int& C) { const int st = b / 1024, sb = b % 1024, swz = sb ^ (((sb >> 9) & 1) << 5); R = (st >> 1) * 16 + swz / 64; C = (st & 1) * 32 + (swz % 64) / 2; }
__host__ __device__ __forceinline__ int perm32(int rho) { const int n = rho >> 4, i = rho & 15; return 8 * (i >> 2) + 4 * n + (i & 3); }

struct Unit { int pm, pn, seg; };
struct Gemm { const bf16_t* A; const bf16_t* Bt; int lda, ldb, K; const bf16_t* A2; const bf16_t* Bt2; };

struct Order {
    int nM, nN, nwg, G, c, extra, twoseg;
    __device__ void init(int nM_, int nN_, int G_, int c_, int extra_, int twoseg_ = 0) { nM = nM_; nN = nN_; nwg = nM * nN; G = G_; c = c_; extra = extra_; twoseg = twoseg_; }
    __device__ bool next(int i, Unit& u) const {
        u.seg = twoseg ? (i & 1) : 0; if (twoseg) i >>= 1;
        const long L = (long)i * G + c; if (L >= nwg + extra) return false;
        if (L >= nwg) { const int idx = (int)L - nwg, k = idx % 10; u.pm = 128 + idx / 10; u.pn = k < 2 ? 4 + k : 8 + k; return true; }
        int wgid = (int)L; { const int q = nwg / NXCD, r = nwg % NXCD, xcd = wgid % NXCD, off = wgid / NXCD; wgid = (xcd < r ? xcd * (q + 1) : r * (q + 1) + (xcd - r) * q) + off; }
        const int nig = WGM * nN, gid = wgid / nig, fm = gid * WGM, gsz = (nM - fm) < WGM ? (nM - fm) : WGM;
        u.pm = fm + ((wgid % nig) % gsz); u.pn = (wgid % nig) / gsz; return true;
    }
};

typedef f32x4 Acc[2][2][4][2];

struct EpiBf16 {
    static constexpr bool PERM = true;
    __device__ __forceinline__ static bool keep_acc(const Unit&) { return false; }
    bf16_t* O; int ldc;
    __device__ __forceinline__ void operator()(Acc& acc, const Unit& u, int wr, int wc, int fr, int fq) const {
        const int row0 = u.pm * BM + wr * 64 + fr, col0 = u.pn * BM + wc * 32 + 8 * fq;
#pragma unroll
        for (int ai = 0; ai < 2; ++ai)
#pragma unroll
            for (int m = 0; m < 4; ++m) { bf16_t* rowp = O + (size_t)(row0 + ai * HALF + m * 16) * ldc + col0;
#pragma unroll
                for (int bj = 0; bj < 2; ++bj) { const f32x4 v0 = acc[ai][bj][m][0], v1 = acc[ai][bj][m][1];
                    u32x4 w; w.x = cvt_pk_bf16(v0[0], v0[1]); w.y = cvt_pk_bf16(v0[2], v0[3]); w.z = cvt_pk_bf16(v1[0], v1[1]); w.w = cvt_pk_bf16(v1[2], v1[3]);
                    *(u32x4*)(rowp + bj * HALF) = w; } }
    }
};

struct EpiQKV {
    static constexpr bool PERM = true;
    __device__ __forceinline__ static bool keep_acc(const Unit&) { return false; }
    bf16_t* O; const float* rc; const float* rs;
    __device__ __forceinline__ void operator()(Acc& acc, const Unit& u, int wr, int wc, int fr, int fq) const {
        const int pn = u.pn; int mode = 0;
        if (pn <= 4) mode = (u.pm < 128) ? 1 : 0; else if (pn >= 6 && pn <= 9) mode = 2; else if (pn >= 18) mode = 3;
        const float qs = (pn < 4 || mode == 2) ? QSCALE : 1.0f;
        const int row0 = u.pm * BM + wr * 64 + fr, col0 = pn * BM + wc * 32 + 8 * fq;
        const int ridx = 16 * (wc & 1) + 4 * fq;
        f32x4 cq[2][4], sq[2][4];
#pragma unroll
        for (int ai = 0; ai < 2; ++ai)
#pragma unroll
            for (int m = 0; m < 4; ++m) { cq[ai][m] = (f32x4){1.f, 1.f, 1.f, 1.f}; sq[ai][m] = (f32x4){0.f, 0.f, 0.f, 0.f};
                if (mode == 1) { const int t = (row0 + ai * HALF + m * 16) & (SEQ - 1); const int pos = (wc >> 1) ? (t & 63) : (t >> 6); cq[ai][m] = *(const f32x4*)(rc + pos * 32 + ridx); sq[ai][m] = *(const f32x4*)(rs + pos * 32 + ridx); } }
#pragma unroll
        for (int ai = 0; ai < 2; ++ai)
#pragma unroll
            for (int m = 0; m < 4; ++m) { const int row = row0 + ai * HALF + m * 16; bf16_t* rowp = O + (size_t)row * DIN + col0;
                const f32x4 c4 = cq[ai][m], s4 = sq[ai][m];
#pragma unroll
                for (int bj = 0; bj < 2; ++bj) { f32x4 v0 = acc[ai][bj][m][0], v1 = acc[ai][bj][m][1];
                    if (mode == 1) { const f32x4 o0 = v0 * c4 - v1 * s4, o1 = v1 * c4 + v0 * s4; v0 = o0 * qs; v1 = o1 * qs; }
                    else if (mode == 2) { v0 = v0 * qs; v1 = v1 * qs; }
                    else if (mode == 3) {
#pragma unroll
                        for (int e = 0; e < 4; ++e) { v0[e] = sigmoidf_(v0[e]); v1[e] = sigmoidf_(v1[e]); } }
                    u32x4 w; w.x = cvt_pk_bf16(v0[0], v0[1]); w.y = cvt_pk_bf16(v0[2], v0[3]); w.z = cvt_pk_bf16(v1[0], v1[1]); w.w = cvt_pk_bf16(v1[2], v1[3]);
                    *(u32x4*)(rowp + bj * HALF) = w; } }
    }
};

struct EpiBranch2 {
    static constexpr bool PERM = true;
    __device__ __forceinline__ static bool keep_acc(const Unit& u) { return u.seg == 0; }
    bf16_t* Z; const bf16_t* GA; const bf16_t* GB;
    __device__ __forceinline__ void operator()(Acc& acc, const Unit& u, int wr, int wc, int fr, int fq) const {
        const int row0 = u.pm * BM + wr * 64 + fr, col0 = u.pn * BM + wc * 32 + 8 * fq;
        if (u.seg == 0) {
#pragma unroll
            for (int ai = 0; ai < 2; ++ai)
#pragma unroll
                for (int m = 0; m < 4; ++m) { const size_t ro = (size_t)(row0 + ai * HALF + m * 16) * DIN + col0;
#pragma unroll
                    for (int bj = 0; bj < 2; ++bj) { const u32x4 ga = *(const u32x4*)(GA + ro + bj * HALF), gb = *(const u32x4*)(GB + ro + bj * HALF);
                        f32x4 r0, r1;
                        r0[0] = bf_lo(ga.x) * __builtin_amdgcn_rcpf(fmaxf(bf_lo(gb.x), 1e-20f)); r0[1] = bf_hi(ga.x) * __builtin_amdgcn_rcpf(fmaxf(bf_hi(gb.x), 1e-20f));
                        r0[2] = bf_lo(ga.y) * __builtin_amdgcn_rcpf(fmaxf(bf_lo(gb.y), 1e-20f)); r0[3] = bf_hi(ga.y) * __builtin_amdgcn_rcpf(fmaxf(bf_hi(gb.y), 1e-20f));
                        r1[0] = bf_lo(ga.z) * __builtin_amdgcn_rcpf(fmaxf(bf_lo(gb.z), 1e-20f)); r1[1] = bf_hi(ga.z) * __builtin_amdgcn_rcpf(fmaxf(bf_hi(gb.z), 1e-20f));
                        r1[2] = bf_lo(ga.w) * __builtin_amdgcn_rcpf(fmaxf(bf_lo(gb.w), 1e-20f)); r1[3] = bf_hi(ga.w) * __builtin_amdgcn_rcpf(fmaxf(bf_hi(gb.w), 1e-20f));
                        acc[ai][bj][m][0] *= r0; acc[ai][bj][m][1] *= r1; } }
        } else {
            u32x4 gq[2][4][2];
#pragma unroll
            for (int ai = 0; ai < 2; ++ai)
#pragma unroll
                for (int m = 0; m < 4; ++m)
#pragma unroll
                    for (int bj = 0; bj < 2; ++bj) gq[ai][m][bj] = *(const u32x4*)(GB + (size_t)(row0 + ai * HALF + m * 16) * DIN + col0 + bj * HALF);
#pragma unroll
            for (int ai = 0; ai < 2; ++ai)
#pragma unroll
                for (int m = 0; m < 4; ++m) { const int row = row0 + ai * HALF + m * 16; bf16_t* zp = Z + (size_t)row * DM + col0;
#pragma unroll
                    for (int bj = 0; bj < 2; ++bj) { f32x4 v0 = acc[ai][bj][m][0], v1 = acc[ai][bj][m][1];
                        const u32x4 g = gq[ai][m][bj];
                        v0[0] *= fmaxf(bf_lo(g.x), 1e-20f); v0[1] *= fmaxf(bf_hi(g.x), 1e-20f); v0[2] *= fmaxf(bf_lo(g.y), 1e-20f); v0[3] *= fmaxf(bf_hi(g.y), 1e-20f);
                        v1[0] *= fmaxf(bf_lo(g.z), 1e-20f); v1[1] *= fmaxf(bf_hi(g.z), 1e-20f); v1[2] *= fmaxf(bf_lo(g.w), 1e-20f); v1[3] *= fmaxf(bf_hi(g.w), 1e-20f);
                        u32x4 w; w.x = cvt_pk_bf16(v0[0], v0[1]); w.y = cvt_pk_bf16(v0[2], v0[3]); w.z = cvt_pk_bf16(v1[0], v1[1]); w.w = cvt_pk_bf16(v1[2], v1[3]);
                        *(u32x4*)(zp + bj * HALF) = w; } }
        }
    }
};

struct EpiUp {
    static constexpr bool PERM = true;
    __device__ __forceinline__ static bool keep_acc(const Unit&) { return false; }
    bf16_t* ACT; bf16_t* HALO; const float* cw; const float* cb;
    __device__ __forceinline__ void operator()(Acc& acc, const Unit& u, int wr, int wc, int fr, int fq) const {
        const int cc = wc * 32 + 8 * fq, acol = u.pn * HALF + cc;
        f32x4 cwa[2][4], cwg[2][4];
#pragma unroll
        for (int n = 0; n < 2; ++n) { const int ca = acol + 4 * n, cg_ = DFF + acol + 4 * n;
            cwa[n][0] = *(const f32x4*)(cw + ca); cwa[n][1] = *(const f32x4*)(cw + DUP + ca); cwa[n][2] = *(const f32x4*)(cw + 2 * DUP + ca); cwa[n][3] = *(const f32x4*)(cb + ca);
            cwg[n][0] = *(const f32x4*)(cw + cg_); cwg[n][1] = *(const f32x4*)(cw + DUP + cg_); cwg[n][2] = *(const f32x4*)(cw + 2 * DUP + cg_); cwg[n][3] = *(const f32x4*)(cb + cg_); }
#pragma unroll
        for (int ai = 0; ai < 2; ++ai) { const int chunk = u.pm * 4 + ai * 2 + wr;
            if (fr < 2 || fr >= 14) { const int slot = fr < 2 ? fr : fr - 12;
                bf16_t* hp = HALO + ((size_t)(chunk * 4 + slot) * DUP + u.pn * BM + cc);
#pragma unroll
                for (int bj = 0; bj < 2; ++bj) { const f32x4 v0 = fr < 2 ? acc[ai][bj][0][0] : acc[ai][bj][3][0], v1 = fr < 2 ? acc[ai][bj][0][1] : acc[ai][bj][3][1];
                    u32x4 w; w.x = cvt_pk_bf16(v0[0], v0[1]); w.y = cvt_pk_bf16(v0[2], v0[3]); w.z = cvt_pk_bf16(v1[0], v1[1]); w.w = cvt_pk_bf16(v1[2], v1[3]);
                    *(u32x4*)(hp + bj * HALF) = w; } } }
#pragma unroll
        for (int n = 0; n < 2; ++n) {
            const f32x4 wa0 = cwa[n][0], wa1 = cwa[n][1], wa2 = cwa[n][2], ba = cwa[n][3];
            const f32x4 wg0 = cwg[n][0], wg1 = cwg[n][1], wg2 = cwg[n][2], bg = cwg[n][3];
#pragma unroll
            for (int k = 0; k < 4; ++k)
#pragma unroll
                for (int ai = 0; ai < 2; ++ai) {
                    float ra[4], rg[4], pa[4], pg[4], na[4], ng[4];
#pragma unroll
                    for (int m = 0; m < 4; ++m) { ra[m] = acc[ai][0][m][n][k]; rg[m] = acc[ai][1][m][n][k]; }
#pragma unroll
                    for (int m = 0; m < 4; ++m) {
                        const float oa = m > 0 ? dppf<0x121>(ra[m - 1], ra[m - 1]) : 0.f, og = m > 0 ? dppf<0x121>(rg[m - 1], rg[m - 1]) : 0.f;
                        pa[m] = dppf<0x111>(oa, ra[m]); pg[m] = dppf<0x111>(og, rg[m]);
                        const float qa = m < 3 ? dppf<0x12F>(ra[m + 1], ra[m + 1]) : 0.f, qg = m < 3 ? dppf<0x12F>(rg[m + 1], rg[m + 1]) : 0.f;
                        na[m] = dppf<0x101>(qa, ra[m]); ng[m] = dppf<0x101>(qg, rg[m]);
                    }
#pragma unroll
                    for (int m = 0; m < 4; ++m) {
                        const float va = ba[k] + wa0[k] * pa[m] + wa1[k] * ra[m] + wa2[k] * na[m];
                        const float vg = bg[k] + wg0[k] * pg[m] + wg1[k] * rg[m] + wg2[k] * ng[m];
                        acc[ai][0][m][n][k] = va * vg * sigmoidf_(vg);
                    }
                }
        }
        const int row0 = u.pm * BM + wr * 64 + fr;
#pragma unroll
        for (int ai = 0; ai < 2; ++ai)
#pragma unroll
            for (int m = 0; m < 4; ++m) { const f32x4 v0 = acc[ai][0][m][0], v1 = acc[ai][0][m][1];
                u32x4 w; w.x = cvt_pk_bf16(v0[0], v0[1]); w.y = cvt_pk_bf16(v0[2], v0[3]); w.z = cvt_pk_bf16(v1[0], v1[1]); w.w = cvt_pk_bf16(v1[2], v1[3]);
                *(u32x4*)(ACT + (size_t)(row0 + ai * HALF + m * 16) * DFF + acol) = w; }
    }
};

template <class Epi, class Sched, bool ALIGN_EPI, bool SP2>
__device__ __forceinline__ void gemm_phase(LAS unsigned char* lds, const Gemm g, const Sched& S, const Epi& E) {
    int tid = threadIdx.x; asm volatile("" : "+v"(tid));
    const int wid = __builtin_amdgcn_readfirstlane(tid >> 6), lane = tid & 63, wr = wid >> 2, wc = wid & 3, fr = lane & 15, fq = lane >> 4;
    const int K = g.K, nt = K / BK;
    unsigned voffA[2], voffB[2];
#pragma unroll
    for (int i = 0; i < 2; ++i) { int R, C; stage_rc(tid * 16 + i * 8192, R, C); const int Rb = Epi::PERM ? ((R & ~31) + perm32(R & 31)) : R;
        voffA[i] = (unsigned)(R * g.lda + C) * 2u; voffB[i] = (unsigned)(Rb * g.ldb + C) * 2u; }
    const size_t kstep = (size_t)(BK * 2);
    const size_t hA = (size_t)HALF * g.lda * 2, hB = (size_t)HALF * g.ldb * 2;
    const size_t tA = 2 * hA, tB = 2 * hB;
    const unsigned ldsw = (unsigned)wid * 1024u;
    const int aoff = lds_byte(wr * 64 + fr, fq * 8), boff = lds_byte(wc * 32 + fr, fq * 8);
#define PG8_SA(b, h) (((b) * 2 + (h)) * HTB)
#define PG8_SB(b, h) ((4 + (b) * 2 + (h)) * HTB)
#define PG8_STAGE(bufoff, gbase, voff) do { _Pragma("unroll") for (int _i = 0; _i < 2; ++_i) \
        __builtin_amdgcn_global_load_lds((const unsigned*)((const char*)(gbase) + (voff)[_i]), (LAS unsigned*)(lds + (bufoff) + ldsw + _i * 8192), 16, 0, 0); } while (0)
#define PG8_LDA(dst, b, h) do { _Pragma("unroll") for (int m = 0; m < 4; ++m) _Pragma("unroll") for (int k = 0; k < 2; ++k) dst[m][k] = *(const LAS bf16x8*)(lds + PG8_SA(b, h) + aoff + m * 2048 + k * 1024); } while (0)
#define PG8_LDB(dst, b, h) do { _Pragma("unroll") for (int n = 0; n < 2; ++n) _Pragma("unroll") for (int k = 0; k < 2; ++k) dst[n][k] = *(const LAS bf16x8*)(lds + PG8_SB(b, h) + boff + n * 2048 + k * 1024); } while (0)
#define PG8_MMA(ai, bj, At, Bt) do { __builtin_amdgcn_s_setprio(1); _Pragma("unroll") for (int k = 0; k < 2; ++k) _Pragma("unroll") for (int n = 0; n < 2; ++n) _Pragma("unroll") for (int m = 0; m < 4; ++m) \
        acc[ai][bj][m][n] = __builtin_amdgcn_mfma_f32_16x16x32_bf16(Bt[n][k], At[m][k], acc[ai][bj][m][n], 0, 0, 0); __builtin_amdgcn_s_setprio(0); } while (0)
#define PG8_WAIT_V(n) asm volatile("s_waitcnt vmcnt(" #n ")" ::: "memory")
#define PG8_WAIT_L(n) asm volatile("s_waitcnt lgkmcnt(" #n ")" ::: "memory")
#define PG8_BAR __builtin_amdgcn_s_barrier()
#define PG8_SCHED __builtin_amdgcn_sched_barrier(0)
    Unit cur, nxt; int ui = 0;
    if (!S.next(0, cur)) return;
    Acc acc;
#pragma unroll
    for (int a = 0; a < 2; ++a)
#pragma unroll
        for (int b = 0; b < 2; ++b)
#pragma unroll
            for (int m = 0; m < 4; ++m)
#pragma unroll
                for (int n = 0; n < 2; ++n) acc[a][b][m][n] = (f32x4){0.f, 0.f, 0.f, 0.f};
    bf16x8 At[4][2], B0[2][2], B1[2][2];
    const char* cA = (const char*)(cur.seg ? g.A2 : g.A) + (size_t)cur.pm * tA; const char* cB = (const char*)(cur.seg ? g.Bt2 : g.Bt) + (size_t)cur.pn * tB;
    if constexpr (SP2) {
        PG8_STAGE(PG8_SB(0, 0), cB, voffB); PG8_STAGE(PG8_SB(0, 1), cB + hB, voffB); PG8_STAGE(PG8_SA(0, 0), cA, voffA); PG8_STAGE(PG8_SA(0, 1), cA + hA, voffA);
        if (wr == 1) PG8_BAR;
        PG8_WAIT_V(2); PG8_BAR;
        PG8_STAGE(PG8_SB(1, 0), cB + kstep, voffB); PG8_STAGE(PG8_SA(1, 0), cA + kstep, voffA); PG8_STAGE(PG8_SB(1, 1), cB + hB + kstep, voffB);
        PG8_WAIT_V(6); PG8_BAR;
    } else {
        PG8_STAGE(PG8_SB(0, 0), cB, voffB); PG8_STAGE(PG8_SA(0, 0), cA, voffA); PG8_STAGE(PG8_SB(0, 1), cB + hB, voffB); PG8_STAGE(PG8_SA(0, 1), cA + hA, voffA);
        if (wr == 1) PG8_BAR;
        PG8_WAIT_V(4); PG8_BAR;
        PG8_STAGE(PG8_SB(1, 0), cB + kstep, voffB); PG8_STAGE(PG8_SA(1, 0), cA + kstep, voffA); PG8_STAGE(PG8_SB(1, 1), cB + hB + kstep, voffB);
        PG8_WAIT_V(6); PG8_BAR;
    }
    for (;;) {
        const bool has_next = S.next(ui + 1, nxt);
        const char* nA = has_next ? (const char*)(nxt.seg ? g.A2 : g.A) + (size_t)nxt.pm * tA : cA; const char* nB = has_next ? (const char*)(nxt.seg ? g.Bt2 : g.Bt) + (size_t)nxt.pn * tB : cB;
        for (int t = 0; t < nt; t += 2) {
            const bool last = (t == nt - 2);
            const char* a1 = cA + (size_t)(t + 1) * kstep;
            const char* a2 = last ? nA : cA + (size_t)(t + 2) * kstep; const char* b2 = last ? nB : cB + (size_t)(t + 2) * kstep;
            const char* a3 = a2 + kstep; const char* b3 = b2 + kstep;
            if constexpr (SP2) {
            PG8_LDB(B0, 0, 0); PG8_LDB(B1, 0, 1); PG8_SCHED; PG8_LDA(At, 0, 0); PG8_STAGE(PG8_SA(1, 1), a1 + hA, voffA);
            PG8_WAIT_V(8); PG8_WAIT_L(0); PG8_BAR; PG8_MMA(0, 0, At, B0); PG8_MMA(0, 1, At, B1); PG8_BAR; PG8_SCHED;
            PG8_LDA(At, 0, 1); PG8_STAGE(PG8_SB(0, 0), b2, voffB); PG8_STAGE(PG8_SB(0, 1), b2 + hB, voffB); PG8_STAGE(PG8_SA(0, 0), a2, voffA);
            PG8_WAIT_V(8); PG8_WAIT_L(0); PG8_BAR; PG8_MMA(1, 0, At, B0); PG8_MMA(1, 1, At, B1); PG8_BAR; PG8_SCHED;
            PG8_LDB(B0, 1, 0); PG8_LDB(B1, 1, 1); PG8_SCHED; PG8_LDA(At, 1, 0); PG8_STAGE(PG8_SA(0, 1), a2 + hA, voffA);
            PG8_WAIT_V(8); PG8_WAIT_L(0); PG8_BAR; PG8_MMA(0, 0, At, B0); PG8_MMA(0, 1, At, B1); PG8_BAR; PG8_SCHED;
            PG8_LDA(At, 1, 1); PG8_STAGE(PG8_SB(1, 0), b3, voffB); PG8_STAGE(PG8_SB(1, 1), b3 + hB, voffB); PG8_STAGE(PG8_SA(1, 0), a3, voffA);
            PG8_WAIT_V(8); PG8_WAIT_L(0); PG8_BAR; PG8_MMA(1, 0, At, B0); PG8_MMA(1, 1, At, B1); PG8_BAR; PG8_SCHED;
            } else {
            PG8_LDB(B0, 0, 0); PG8_SCHED; PG8_LDA(At, 0, 0); PG8_STAGE(PG8_SA(1, 1), a1 + hA, voffA);
            PG8_WAIT_L(8); PG8_BAR; PG8_WAIT_L(0); PG8_MMA(0, 0, At, B0); PG8_BAR; PG8_SCHED;
            PG8_LDB(B1, 0, 1); PG8_STAGE(PG8_SB(0, 0), b2, voffB);
            PG8_BAR; PG8_WAIT_L(0); PG8_MMA(0, 1, At, B1); PG8_BAR;
            PG8_LDA(At, 0, 1); PG8_STAGE(PG8_SA(0, 0), a2, voffA);
            PG8_BAR; PG8_WAIT_L(0); PG8_MMA(1, 0, At, B0); PG8_BAR; PG8_SCHED;
            PG8_STAGE(PG8_SB(0, 1), b2 + hB, voffB);
            PG8_WAIT_V(6); PG8_BAR; PG8_MMA(1, 1, At, B1); PG8_BAR;
            PG8_LDB(B0, 1, 0); PG8_SCHED; PG8_LDA(At, 1, 0); PG8_STAGE(PG8_SA(0, 1), a2 + hA, voffA);
            PG8_WAIT_L(8); PG8_BAR; PG8_WAIT_L(0); PG8_MMA(0, 0, At, B0); PG8_BAR; PG8_SCHED;
            PG8_LDB(B1, 1, 1); PG8_STAGE(PG8_SB(1, 0), b3, voffB);
            PG8_BAR; PG8_WAIT_L(0); PG8_MMA(0, 1, At, B1); PG8_BAR;
            PG8_LDA(At, 1, 1); PG8_STAGE(PG8_SA(1, 0), a3, voffA);
            PG8_BAR; PG8_WAIT_L(0); PG8_MMA(1, 0, At, B0); PG8_BAR; PG8_SCHED;
            PG8_STAGE(PG8_SB(1, 1), b3 + hB, voffB);
            PG8_WAIT_V(6); PG8_BAR; PG8_MMA(1, 1, At, B1); PG8_BAR;
            }
        }
        if constexpr (ALIGN_EPI) { if (wr == 0) PG8_BAR; }
        E(acc, cur, wr, wc, fr, fq);
        if (!has_next) break;
        if (!Epi::keep_acc(cur))
#pragma unroll
        for (int a = 0; a < 2; ++a)
#pragma unroll
            for (int b = 0; b < 2; ++b)
#pragma unroll
                for (int m = 0; m < 4; ++m)
#pragma unroll
                    for (int n = 0; n < 2; ++n) acc[a][b][m][n] = (f32x4){0.f, 0.f, 0.f, 0.f};
        cur = nxt; cA = nA; cB = nB; ++ui;
        if constexpr (ALIGN_EPI) { if (wr == 1) PG8_BAR; }
    }
    PG8_WAIT_V(0);
    if constexpr (!ALIGN_EPI) { if (wr == 0) PG8_BAR; }
    PG8_BAR;
#undef PG8_SA
#undef PG8_SB
#undef PG8_STAGE
#undef PG8_LDA
#undef PG8_LDB
#undef PG8_MMA
#undef PG8_WAIT_V
#undef PG8_WAIT_L
#undef PG8_BAR
#undef PG8_SCHED
}
}

namespace att {
constexpr int SHM_V = 16384, SHM_K = 16384;
constexpr int OFF_V = 0, OFF_K = 3 * SHM_V, OFF_WS = OFF_K + 3 * SHM_K, OFF_TBL = OFF_WS + 8 * 256 + 1024;
#define KSWZ(row, colB) ((row) * 256 + ((colB) ^ (((row) & 7) << 4)))
#define SBAR() __builtin_amdgcn_sched_barrier(0)
__device__ __forceinline__ int crow(int r, int hi) { return (r & 3) + 8 * (r >> 2) + 4 * hi; }
__device__ __forceinline__ int v_st(int k, int c) { const int kk = (k & ~0xC) | ((k & 4) << 1) | ((k & 8) >> 1); return ((kk >> 3) * 4 + (c >> 5)) * 512 + ((kk & 7) * 32 + (c & 31)) * 2; }
__device__ __forceinline__ int v_rd_base(int lane) { return ((lane & 3) << 3) | (((lane >> 2) & 3) << 6) | (((lane >> 4) & 1) << 5) | (((lane >> 5) & 1) << 8); }
constexpr int v_rd_off(int d0, int ks, int half) { return d0 * 512 + ks * 4096 + half * 2048; }
template <int OFF> __device__ __forceinline__ s16x4 tr_read(int vb) {
    s16x4 r; asm volatile("ds_read_b64_tr_b16 %0, %1 offset:%2" : "=&v"(r) : "v"(vb), "i"(OFF) : "memory"); return r;
}
#define PK(L, H) (bf16x8){L[0], L[1], L[2], L[3], H[0], H[1], H[2], H[3]}
struct VFrag { s16x4 l0, h0, l1, h1, l2, h2, l3, h3; };
template <int D0> __device__ __forceinline__ void pv_reads(VFrag& f, int vb) {
    f.l0 = tr_read<v_rd_off(D0, 0, 0)>(vb); f.h0 = tr_read<v_rd_off(D0, 0, 1)>(vb); f.l1 = tr_read<v_rd_off(D0, 1, 0)>(vb); f.h1 = tr_read<v_rd_off(D0, 1, 1)>(vb);
    f.l2 = tr_read<v_rd_off(D0, 2, 0)>(vb); f.h2 = tr_read<v_rd_off(D0, 2, 1)>(vb); f.l3 = tr_read<v_rd_off(D0, 3, 0)>(vb); f.h3 = tr_read<v_rd_off(D0, 3, 1)>(vb);
}
__device__ __forceinline__ void pv_mma(f32x16& od, const VFrag& f, bf16x8 pa0, bf16x8 pa1, bf16x8 pa2, bf16x8 pa3) {
    od = __builtin_amdgcn_mfma_f32_32x32x16_bf16(pa0, PK(f.l0, f.h0), od, 0, 0, 0);
    od = __builtin_amdgcn_mfma_f32_32x32x16_bf16(pa1, PK(f.l1, f.h1), od, 0, 0, 0);
    od = __builtin_amdgcn_mfma_f32_32x32x16_bf16(pa2, PK(f.l2, f.h2), od, 0, 0, 0);
    od = __builtin_amdgcn_mfma_f32_32x32x16_bf16(pa3, PK(f.l3, f.h3), od, 0, 0, 0);
}
__device__ __forceinline__ void pv_all(f32x16 (&o)[4], int vb, bf16x8 pa0, bf16x8 pa1, bf16x8 pa2, bf16x8 pa3) {
    VFrag fa, fb;
    pv_reads<0>(fa, vb); pv_reads<1>(fb, vb);
    asm volatile("s_waitcnt lgkmcnt(8)" ::: "memory"); SBAR(); pv_mma(o[0], fa, pa0, pa1, pa2, pa3); SBAR();
    pv_reads<2>(fa, vb);
    asm volatile("s_waitcnt lgkmcnt(8)" ::: "memory"); SBAR(); pv_mma(o[1], fb, pa0, pa1, pa2, pa3); SBAR();
    pv_reads<3>(fb, vb);
    asm volatile("s_waitcnt lgkmcnt(8)" ::: "memory"); SBAR(); pv_mma(o[2], fa, pa0, pa1, pa2, pa3); SBAR();
    asm volatile("s_waitcnt lgkmcnt(0)" ::: "memory"); SBAR(); pv_mma(o[3], fb, pa0, pa1, pa2, pa3);
}
#undef PK
template <bool ISB>
__device__ __forceinline__ void attn_unit(LAS unsigned char* lds, const bf16_t* __restrict__ QKVG, bf16_t* __restrict__ OAB, const float* __restrict__ sink, const float* __restrict__ rpb,
                                          int b, int hh, int blk) {
    int tid = threadIdx.x; asm volatile("" : "+v"(tid));
    const int wid = __builtin_amdgcn_readfirstlane(tid >> 6), lane = tid & 63, r32 = lane & 31, hi = lane >> 5;
    LAS unsigned char* V_lds = lds + OFF_V; LAS unsigned char* K_lds = lds + OFF_K;
    LAS float* wsc = (LAS float*)(lds + OFF_WS) + wid * 64;
    LAS float* tbl = (LAS float*)(lds + OFF_TBL);
    int qrow0, qcol, kcol, vcol, ocol, nt, lat0;
    int qoff = (wid & 1) * 32 + r32;
    int rq = 0, wlo = 0;
    if (ISB) {
        const int r0 = blk * 4; rq = r0 + (wid >> 1); wlo = min(max(rq - 4, 0), 120);
        const int kr0 = min(max(r0 - 4, 0), 120), kr1 = min(max(r0 + 3 - 4, 0), 120) + 8;
        lat0 = kr0; nt = 4 + (kr1 - kr0);
        qrow0 = b * SEQ + rq * 64 + (wid & 1) * 32; qcol = C_QB + hh * 128; kcol = C_KB + hh * 128; vcol = C_VB + hh * 128; ocol = 1024 + hh * 128;
    } else {
        const int t0 = blk * 64; const int jl0 = t0 >= 128 ? 0 : (128 - t0) / 64; const int jl1 = min(5, (SEQ + 128 - t0) / 64);
        lat0 = jl0; nt = 4 + (jl1 - jl0);
        const int head = hh * 4 + (wid >> 1);
        qrow0 = b * SEQ + t0 + (wid & 1) * 32; qcol = C_QA + head * 128; kcol = C_KA + hh * 128; vcol = C_VA + hh * 128; ocol = head * 128;
    }
    auto tile_row = [&](int i) -> int {
        if (i < 4) return MTOK + b * CTXL + 64 * i;
        if (ISB) return b * SEQ + (lat0 + i - 4) * 64;
        return b * SEQ + blk * 64 - 128 + 64 * (lat0 + i - 4);
    };
    bf16x8 qr[8];
    { const bf16_t* Qw = QKVG + (size_t)(qrow0 + r32) * DIN + qcol + hi * 8;
#pragma unroll
      for (int d0 = 0; d0 < 8; ++d0) qr[d0] = *(const bf16x8*)(Qw + d0 * 16); }
    float m_reg, l_reg;
    if (ISB) { m_reg = NEGBIG; l_reg = 0.f; for (int i = tid; i < 465; i += 512) tbl[i] = rpb[hh * 465 + i] * LOG2E; }
    else { m_reg = sink[hh * 4 + (wid >> 1)] * LOG2E; l_reg = 1.f; }
    f32x16 o[4];
#pragma unroll
    for (int d = 0; d < 4; ++d)
#pragma unroll
        for (int r = 0; r < 16; ++r) o[d][r] = 0.f;
    const int vb0 = (int)(uintptr_t)V_lds + v_rd_base(lane);
    unsigned koff[2], voff[2];
#pragma unroll
    for (int i = 0; i < 2; ++i) { const int g = (i * 8 + wid) * 64 + lane;
        { const int row = g >> 4, c = (g & 15) ^ (row & 7); koff[i] = (unsigned)(row * DIN + c * 8) * 2u; }
        { const int sub = g >> 5, kk = (sub >> 2) * 8 + ((g >> 2) & 7), c = (sub & 3) * 32 + (g & 3) * 8, k = (kk & ~0xC) | ((kk & 4) << 1) | ((kk & 8) >> 1); voff[i] = (unsigned)(k * DIN + c) * 2u; } }
    const unsigned ldsw = (unsigned)wid * 1024u;
    const int kb0 = r32 * 256 + (((0 + hi) ^ (r32 & 7)) << 4), kb1 = r32 * 256 + (((2 + hi) ^ (r32 & 7)) << 4), kb2 = r32 * 256 + (((4 + hi) ^ (r32 & 7)) << 4), kb3 = r32 * 256 + (((6 + hi) ^ (r32 & 7)) << 4);
#define SSTAGE(R0, bb) do { const char* gk_ = (const char*)(QKVG + (size_t)(R0) * DIN + kcol); const char* gv_ = (const char*)(QKVG + (size_t)(R0) * DIN + vcol); \
        _Pragma("unroll") for (int _i = 0; _i < 2; ++_i) { \
            __builtin_amdgcn_global_load_lds((const unsigned*)(gk_ + koff[_i]), (LAS unsigned*)(K_lds + (bb) * SHM_K + ldsw + _i * 8192), 16, 0, 0); \
            __builtin_amdgcn_global_load_lds((const unsigned*)(gv_ + voff[_i]), (LAS unsigned*)(V_lds + (bb) * SHM_V + ldsw + _i * 8192), 16, 0, 0); } } while (0)
#define PK4(P, BASE, OUT) do { unsigned a0 = cvt_pk_bf16(P[BASE + 0], P[BASE + 1]), a1 = cvt_pk_bf16(P[BASE + 2], P[BASE + 3]);   \
    unsigned b0 = cvt_pk_bf16(P[BASE + 4], P[BASE + 5]), b1 = cvt_pk_bf16(P[BASE + 6], P[BASE + 7]);                              \
    auto r0 = __builtin_amdgcn_permlane32_swap(a0, b0, false, false); auto r1 = __builtin_amdgcn_permlane32_swap(a1, b1, false, false); \
    u32x4 w = {r0[0], r1[0], r0[1], r1[1]}; OUT = *reinterpret_cast<bf16x8*>(&w); } while (0)
#define ATT_FINISH(VS) do { \
        float pmax = p0[0]; \
        _Pragma("unroll") for (int r = 1; r < 16; ++r) pmax = fmaxf(pmax, p0[r]); \
        _Pragma("unroll") for (int r = 0; r < 16; ++r) pmax = fmaxf(pmax, p1[r]); \
        { auto rr = __builtin_amdgcn_permlane32_swap(__float_as_uint(pmax), __float_as_uint(pmax), false, false); \
          pmax = fmaxf(__uint_as_float(rr[0]), __uint_as_float(rr[1])); } \
        if (!__all(pmax - m_reg <= 8.0f)) { \
            const float mn = fmaxf(m_reg, pmax); const float alpha = __builtin_amdgcn_exp2f(m_reg - mn); m_reg = mn; l_reg *= alpha; \
            if (hi == 0) wsc[r32] = alpha; asm volatile("s_waitcnt lgkmcnt(0)" ::: "memory"); \
            _Pragma("unroll") for (int r = 0; r < 16; ++r) { const float al = wsc[crow(r, hi)]; \
                _Pragma("unroll") for (int d = 0; d < 4; ++d) o[d][r] *= al; } \
            asm volatile("s_waitcnt lgkmcnt(0)" ::: "memory"); } \
        float ps = 0.f; \
        _Pragma("unroll") for (int r = 0; r < 16; ++r) { p0[r] = __builtin_amdgcn_exp2f(p0[r] - m_reg); ps += p0[r]; } \
        _Pragma("unroll") for (int r = 0; r < 16; ++r) { p1[r] = __builtin_amdgcn_exp2f(p1[r] - m_reg); ps += p1[r]; } \
        { auto rr = __builtin_amdgcn_permlane32_swap(__float_as_uint(ps), __float_as_uint(ps), false, false); \
          ps = __uint_as_float(rr[0]) + __uint_as_float(rr[1]); } \
        l_reg += ps; \
        bf16x8 pa0, pa1, pa2, pa3; \
        PK4(p0, 0, pa0); PK4(p0, 8, pa1); PK4(p1, 0, pa2); PK4(p1, 8, pa3); \
        pv_all(o, vb0 + (VS) * SHM_V, pa0, pa1, pa2, pa3); } while (0)
    SSTAGE(tile_row(0), 0); asm volatile("s_waitcnt vmcnt(0) lgkmcnt(0)" ::: "memory"); __builtin_amdgcn_s_barrier(); asm volatile("" ::: "memory");
    const bool late = wid >= 4; bool pending = false; int bprev = 0;
    f32x16 p0, p1;
#pragma unroll
    for (int r = 0; r < 16; ++r) { p0[r] = 0.f; p1[r] = 0.f; }
    int bb = 0, bn = 1;
    for (int i = 0; i < nt; ++i) {
        if (i + 1 < nt) SSTAGE(tile_row(i + 1), bn);
        if (late && pending) { ATT_FINISH(bprev); pending = false; }
        bool active = true; int dr = 0, mmode = 0;
        if (ISB) { if (i >= 4) { const int kr = lat0 + i - 4; active = (kr >= wlo) && (kr < wlo + 8); dr = kr - rq + 7; } }
        else { if (i >= 4) { const int jl = lat0 + i - 4; mmode = jl == 0 ? 1 : (jl == 4 ? 2 : 0); } }
        if (active) {
#pragma unroll
            for (int r = 0; r < 16; ++r) { p0[r] = 0.f; p1[r] = 0.f; }
            const LAS unsigned char* Ks = K_lds + bb * SHM_K;
#define KADDR(d0) (Ks + (((d0) & 3) == 0 ? kb0 : ((d0) & 3) == 1 ? kb1 : ((d0) & 3) == 2 ? kb2 : kb3) + ((d0) >> 2) * 128)
#define LOADG(F, g) do { F[0] = *(const LAS bf16x8*)(KADDR(2 * (g))); F[1] = *(const LAS bf16x8*)(KADDR(2 * (g)) + 8192); F[2] = *(const LAS bf16x8*)(KADDR(2 * (g) + 1)); F[3] = *(const LAS bf16x8*)(KADDR(2 * (g) + 1) + 8192); } while (0)
#define MMAG(F, g) do { p0 = __builtin_amdgcn_mfma_f32_32x32x16_bf16(F[0], qr[2 * (g)], p0, 0, 0, 0); p1 = __builtin_amdgcn_mfma_f32_32x32x16_bf16(F[1], qr[2 * (g)], p1, 0, 0, 0); \
                p0 = __builtin_amdgcn_mfma_f32_32x32x16_bf16(F[2], qr[2 * (g) + 1], p0, 0, 0, 0); p1 = __builtin_amdgcn_mfma_f32_32x32x16_bf16(F[3], qr[2 * (g) + 1], p1, 0, 0, 0); } while (0)
            { bf16x8 fa[4], fb[4];
              LOADG(fa, 0); LOADG(fb, 1); SBAR();
              MMAG(fa, 0); SBAR(); LOADG(fa, 2); SBAR();
              MMAG(fb, 1); SBAR(); LOADG(fb, 3); SBAR();
              MMAG(fa, 2); SBAR();
              MMAG(fb, 3); SBAR(); }
#undef KADDR
#undef LOADG
#undef MMAG
            int hi4 = 4 * hi; asm volatile("" : "+v"(hi4));
            if (ISB) {
                if (i >= 4) { int qo_ = qoff; asm volatile("" : "+v"(qo_)); const int cs = min(max(qo_ - 8, 0), 48); const LAS float* tb = tbl + dr * 31 + 15 - qo_;
#pragma unroll
                    for (int r = 0; r < 16; ++r) { const int c0 = crow(r, 0) + hi4, c1 = 32 + c0;
                        const float b0 = tb[c0], b1 = tb[c1];
                        p0[r] = ((unsigned)(c0 - cs) < 16u) ? p0[r] + b0 : NEGBIG;
                        p1[r] = ((unsigned)(c1 - cs) < 16u) ? p1[r] + b1 : NEGBIG; } }
            } else {
                int qo_ = qoff; asm volatile("" : "+v"(qo_));
                if (mmode == 1) {
#pragma unroll
                    for (int r = 0; r < 16; ++r) { const int c0 = crow(r, 0) + hi4, c1 = 32 + c0; p0[r] = c0 >= qo_ ? p0[r] : NEGBIG; p1[r] = c1 >= qo_ ? p1[r] : NEGBIG; } }
                else if (mmode == 2) {
#pragma unroll
                    for (int r = 0; r < 16; ++r) { const int c0 = crow(r, 0) + hi4, c1 = 32 + c0; p0[r] = c0 <= qo_ ? p0[r] : NEGBIG; p1[r] = c1 <= qo_ ? p1[r] : NEGBIG; } }
            }
            if (!late) { ATT_FINISH(bb); } else { pending = true; bprev = bb; }
        }
        asm volatile("s_waitcnt vmcnt(0) lgkmcnt(0)" ::: "memory");
        __builtin_amdgcn_s_barrier(); asm volatile("" ::: "memory");
        bb = bb == 2 ? 0 : bb + 1; bn = bn == 2 ? 0 : bn + 1;
    }
    if (late && pending) { ATT_FINISH(bprev); }
#undef ATT_FINISH
#undef PK4
#undef SSTAGE
    if (hi == 0) wsc[r32] = l_reg; asm volatile("s_waitcnt lgkmcnt(0)" ::: "memory");
    bf16_t* Ow = OAB + (size_t)qrow0 * DM + ocol;
#pragma unroll
    for (int r = 0; r < 16; ++r) { const int orow = crow(r, hi); const float rl = __builtin_amdgcn_rcpf(wsc[orow]);
#pragma unroll
        for (int d0 = 0; d0 < 4; ++d0) { const unsigned w = cvt_pk_bf16(o[d0][r] * rl, 0.f); Ow[(size_t)orow * DM + d0 * 32 + r32] = (bf16_t)(w & 0xffffu); } }
    asm volatile("s_waitcnt lgkmcnt(0)" ::: "memory");
    __syncthreads();
}
}

template <int MODE> __device__ __forceinline__ int dest_row(int o) {
    if (MODE == 1) { if (o >= C_VA) return o; const int base = o & ~63, w = o & 63; return base + (w < 32 ? 8 * (w >> 2) + (w & 3) : 8 * ((w - 32) >> 2) + 4 + (w & 3)); }
    if (MODE == 2) { if (o < DFF) return 256 * (o >> 7) + (o & 127); const int q = o - DFF; return 256 * (q >> 7) + 128 + (q & 127); }
    return o;
}
template <int MODE> __device__ __forceinline__ void p0_transpose_item(const float* __restrict__ W, int K, int N, bf16_t* __restrict__ WT, LAS float* scr, int item, int lane) {
    const int nblk = N / 32, kb = item / nblk, nb = item % nblk, k0 = 64 * kb, n0 = 32 * nb;
    float tv[32];
#pragma unroll
    for (int i = 0; i < 32; ++i) { const int kk = 2 * i + (lane >> 5); tv[i] = __builtin_nontemporal_load(W + (size_t)(k0 + kk) * N + n0 + (lane & 31)); }
#pragma unroll
    for (int i = 0; i < 32; ++i) { const int kk = 2 * i + (lane >> 5); scr[kk * 33 + (lane & 31)] = tv[i]; }
    asm volatile("s_waitcnt lgkmcnt(0)" ::: "memory");
    const int c = lane & 7;
#pragma unroll
    for (int j = 0; j < 4; ++j) { const int n = (lane >> 3) + 8 * j; const LAS float* s = scr + (8 * c) * 33 + n;
        u32x4 o; o.x = cvt_pk_bf16(s[0 * 33], s[1 * 33]); o.y = cvt_pk_bf16(s[2 * 33], s[3 * 33]); o.z = cvt_pk_bf16(s[4 * 33], s[5 * 33]); o.w = cvt_pk_bf16(s[6 * 33], s[7 * 33]);
        *(u32x4*)(WT + (size_t)dest_row<MODE>(n0 + n) * K + k0 + 8 * c) = o; }
    asm volatile("s_waitcnt lgkmcnt(0)" ::: "memory");
}

struct Args { const float* in[20]; float* out; unsigned char* ws; int ph_lo, ph_hi; };
enum { I_X = 0, I_C, I_CTX, I_CCTX, I_WMOD, I_BMOD, I_GAPRE, I_GAPOST, I_GFPRE, I_GFPOST, I_WIN, I_SINK, I_RPB, I_WBA, I_WBB, I_WO, I_WUP, I_CONVW, I_CONVB, I_WDN };
constexpr int NPHASE = 11;

__global__ void __launch_bounds__(512, 2) fwd_mega(Args args) {
    extern __shared__ __attribute__((aligned(16))) unsigned char lds_raw[];
    LAS unsigned char* lds = (LAS unsigned char*)lds_raw;
    cg::grid_group grid = cg::this_grid();
    const int tid = threadIdx.x, lane = tid & 63, wave = __builtin_amdgcn_readfirstlane(tid >> 6);
    const int G = gridDim.x, bid = blockIdx.x;
    const int gw = bid * 8 + wave, NGW = G * 8;
    unsigned char* ws = args.ws;
    float* MOD = (float*)(ws + WS_MOD); float* ROPEC = (float*)(ws + WS_ROPEC); float* ROPES = (float*)(ws + WS_ROPES);
    bf16_t* WIN = (bf16_t*)(ws + WS_WIN); bf16_t* WBA = (bf16_t*)(ws + WS_WBA); bf16_t* WBB = (bf16_t*)(ws + WS_WBB); bf16_t* WO = (bf16_t*)(ws + WS_WO);
    bf16_t* WUP = (bf16_t*)(ws + WS_WUP); bf16_t* WDN = (bf16_t*)(ws + WS_WDN);
    bf16_t* H = (bf16_t*)(ws + WS_H); bf16_t* Z = H; bf16_t* F = H;
    bf16_t* OAB = (bf16_t*)(ws + WS_OAB); bf16_t* H2 = OAB;
    bf16_t* QKVG = (bf16_t*)(ws + WS_QKVG); bf16_t* Y = (bf16_t*)(ws + WS_Y); bf16_t* ACT = (bf16_t*)(ws + WS_ACT); bf16_t* HALO = (bf16_t*)(ws + WS_HALO);
    const int lo = args.ph_lo, hi_ph = args.ph_hi;
    volatile LAS unsigned* MISC = (volatile LAS unsigned*)(lds + 131072 + 320);
    if (tid < 32) MISC[tid] = 0u;
    __syncthreads();
    XcdBarrier xbar = xcd_barrier_post((unsigned*)(ws + WS_BAR), MISC + 8);
#ifndef REPMASK
#define REPMASK 0
#endif
#define NREP(k) ((((REPMASK) >> (k)) & 1) ? 2 : 1)
#define IN(k) (lo <= (k) && (k) < hi_ph)
#define SEAM(k) do { if (IN(k) && IN((k) + 1)) xcd_barrier(xbar); } while (0)
    if (args.ph_lo > NPHASE) grid.sync();

    for (int rep_ = 0; rep_ < NREP(0); ++rep_) if (IN(0)) {
        int tid = threadIdx.x; asm volatile("" : "+v"(tid)); const int lane = tid & 63; (void)lane;
        LAS float* sl = (LAS float*)lds;
        LAS float* red = sl + 5 * DM;
        const float* c = args.in[I_C]; const float* cctx = args.in[I_CCTX];
        for (int i = tid; i < 5 * DM; i += 512) { const int b = i / DM, k = i % DM; const float v = b < 4 ? c[b * DM + k] : cctx[k]; sl[i] = v / (1.0f + __expf(-v)); }
        __syncthreads();
        const float* wmod = args.in[I_WMOD]; const float* bmod = args.in[I_BMOD];
        for (int item = bid; item < NMOD / 32; item += G) {
            const int n0 = item * 32, cn = tid & 31, kg = tid >> 5;
            float a0 = 0.f, a1 = 0.f, a2 = 0.f, a3 = 0.f, a4 = 0.f;
            const float* wp = wmod + (size_t)(kg * 128) * NMOD + n0 + cn; const LAS float* sp = sl + kg * 128;
#pragma unroll 32
            for (int kk = 0; kk < 128; ++kk) { const float w = __builtin_nontemporal_load(wp + (size_t)kk * NMOD);
                a0 += sp[kk] * w; a1 += sp[DM + kk] * w; a2 += sp[2 * DM + kk] * w; a3 += sp[3 * DM + kk] * w; a4 += sp[4 * DM + kk] * w; }
            LAS float* rp = red + (kg * 32 + cn) * 5; rp[0] = a0; rp[1] = a1; rp[2] = a2; rp[3] = a3; rp[4] = a4;
            __syncthreads();
            if (tid < 160) { const int b = tid >> 5, cn2 = tid & 31; float s = 0.f;
#pragma unroll
                for (int q = 0; q < 16; ++q) s += red[(q * 32 + cn2) * 5 + b];
                MOD[b * NMOD + n0 + cn2] = s + bmod[n0 + cn2]; }
            __syncthreads();
        }
        for (int i = bid * 512 + tid; i < 128 * 32; i += G * 512) { const int pos = i >> 5, j = i & 31;
            const float inv = powf(10000.0f, -(float)j / 32.0f); const float ang = (float)pos * inv; ROPEC[i] = cosf(ang); ROPES[i] = sinf(ang); }
        __syncthreads();
        LAS float* scr = (LAS float*)(lds + wave * 16384);
        constexpr int I_IN = (DM / 64) * (DIN / 32), I_BR = (1024 / 64) * (DM / 32), I_O = (DM / 64) * (DM / 32), I_UP = (DM / 64) * (DUP / 32), I_DN = (DFF / 64) * (DM / 32);
        constexpr int NITEMS = I_IN + 2 * I_BR + I_O + I_UP + I_DN;
        for (int it = gw; it < NITEMS; it += NGW) {
            int r = it;
            if (r < I_IN) { p0_transpose_item<1>(args.in[I_WIN], DM, DIN, WIN, scr, r, lane); continue; } r -= I_IN;
            if (r < I_BR) { p0_transpose_item<0>(args.in[I_WBA], 1024, DM, WBA, scr, r, lane); continue; } r -= I_BR;
            if (r < I_BR) { p0_transpose_item<0>(args.in[I_WBB], 1024, DM, WBB, scr, r, lane); continue; } r -= I_BR;
            if (r < I_O) { p0_transpose_item<0>(args.in[I_WO], DM, DM, WO, scr, r, lane); continue; } r -= I_O;
            if (r < I_UP) { p0_transpose_item<2>(args.in[I_WUP], DM, DUP, WUP, scr, r, lane); continue; } r -= I_UP;
            p0_transpose_item<0>(args.in[I_WDN], DFF, DM, WDN, scr, r, lane);
        }
        __syncthreads();
    }
    SEAM(0);

    for (int rep_ = 0; rep_ < NREP(1); ++rep_) if (IN(1)) {
        int tid = threadIdx.x; asm volatile("" : "+v"(tid)); const int lane = tid & 63; (void)lane;
        const float* x = args.in[I_X]; const float* ctx = args.in[I_CTX]; const float* g = args.in[I_GAPRE];
#define P1_LOAD(V, R) do { const f32x4* xr_ = (const f32x4*)(srcb + (size_t)(R) * DM) + lane; \
        _Pragma("unroll") for (int j = 0; j < 8; ++j) V[j] = __builtin_nontemporal_load(xr_ + 64 * j); } while (0)
#define P1_PROC(V, R) do { float ss_ = 0.f; \
        _Pragma("unroll") for (int j = 0; j < 8; ++j) ss_ += (V[j].x * V[j].x + V[j].y * V[j].y) + (V[j].z * V[j].z + V[j].w * V[j].w); \
        const float rstd_ = 1.0f / sqrtf(wave_sum(ss_) * (1.0f / DM) + EPS); u32x2* hr_ = (u32x2*)(H + (row0 + (size_t)(R)) * DM) + lane; \
        _Pragma("unroll") for (int j = 0; j < 8; ++j) { const f32x4 hv = (V[j] * rstd_) * PA[j] + PB[j]; \
            u32x2 w; w.x = cvt_pk_bf16(hv.x, hv.y); w.y = cvt_pk_bf16(hv.z, hv.w); hr_[64 * j] = w; } } while (0)
        for (int b = 0; b < 5; ++b) {
            const int nrows = b < 4 ? SEQ : MCTX; const size_t row0 = b < 4 ? (size_t)b * SEQ : (size_t)MTOK;
            const float* srcb = b < 4 ? x + (size_t)b * SEQ * DM : ctx; const float* mb = MOD + b * NMOD;
            f32x4 PA[8], PB[8];
#pragma unroll
            for (int j = 0; j < 8; ++j) { const int col = 4 * (lane + 64 * j); PA[j] = *(const f32x4*)(g + col) * (*(const f32x4*)(mb + DM + col) + 1.0f); PB[j] = *(const f32x4*)(mb + col); }
            f32x4 va[8], vb[8]; int r = gw;
            if (r < nrows) P1_LOAD(va, r);
            for (; r < nrows; r += 2 * NGW) {
                const int r2 = r + NGW, r3 = r2 + NGW;
                if (r2 < nrows) P1_LOAD(vb, r2);
                P1_PROC(va, r);
                if (r3 < nrows) P1_LOAD(va, r3);
                if (r2 < nrows) P1_PROC(vb, r2);
            }
        }
#undef P1_LOAD
#undef P1_PROC
    }
    SEAM(1);

    for (int rep_ = 0; rep_ < NREP(2); ++rep_) if (IN(2)) {
        pg8::Gemm g{H, WIN, DM, DM, DM, H, WIN}; pg8::Order S; S.init(MTOK / 256, DIN / 256, G, bid, 40);
        pg8::EpiQKV E{QKVG, ROPEC, ROPES};
        pg8::gemm_phase<pg8::EpiQKV, pg8::Order, true, true>(lds, g, S, E);
    }
    SEAM(2);

    for (int rep_ = 0; rep_ < NREP(3); ++rep_) if (IN(3)) {
        const float* sink = args.in[I_SINK]; const float* rpb = args.in[I_RPB];
#ifndef ATT_REP
#define ATT_REP 1
#endif
        const int vcu = (G % 8 == 0) ? (bid & 7) * (G >> 3) + (bid >> 3) : bid;
        for (int i0 = 0; i0 * G + vcu < 2048 * ATT_REP; ++i0) { const int i = i0 & 7;
            const int idx = (i >> 1) * G + vcu;
            if (idx >= 1024) continue;
            if (i & 1) { const int b = idx >> 8, h = (idx >> 5) & 7, rb = idx & 31; att::attn_unit<true>(lds, QKVG, OAB, sink, rpb, b, h, rb); }
            else { const int b = idx >> 8, kvh = (idx >> 7) & 1, blk = idx & 127; att::attn_unit<false>(lds, QKVG, OAB, sink, rpb, b, kvh, blk); }
        }
    }
    SEAM(3);

    for (int rep_ = 0; rep_ < NREP(4); ++rep_) if (IN(4)) {
        pg8::Gemm g{OAB, WBA, DM, 1024, 1024, OAB + 1024, WBB}; pg8::Order S; S.init(MTOK / 256, DM / 256, G, bid, 0, 1);
        pg8::EpiBranch2 E{Z, QKVG + C_GA, QKVG + C_GB};
        pg8::gemm_phase<pg8::EpiBranch2, pg8::Order, true, true>(lds, g, S, E);
    }
    SEAM(4);

    for (int rep_ = 0; rep_ < NREP(5); ++rep_) if (IN(5)) {
        pg8::Gemm g{Z, WO, DM, DM, DM, Z, WO}; pg8::Order S; S.init(MTOK / 256, DM / 256, G, bid, 0);
        pg8::EpiBf16 E{Y, DM};
        pg8::gemm_phase<pg8::EpiBf16, pg8::Order, true, true>(lds, g, S, E);
    }
    SEAM(5);

    for (int rep_ = 0; rep_ < NREP(6); ++rep_) if (IN(6)) {
        int tid = threadIdx.x; asm volatile("" : "+v"(tid)); const int lane = tid & 63; (void)lane;
        const float* x = args.in[I_X]; const float* gpost = args.in[I_GAPOST]; const float* gpre = args.in[I_GFPRE];
#define P6_LOAD(VX, VY, M) do { const f32x4* xr_ = (const f32x4*)(x + (size_t)(M) * DM) + lane; const u32x2* yr_ = (const u32x2*)(Y + (size_t)(M) * DM) + lane; \
        _Pragma("unroll") for (int j = 0; j < 8; ++j) VY[j] = yr_[64 * j]; \
        _Pragma("unroll") for (int j = 0; j < 8; ++j) VX[j] = __builtin_nontemporal_load(xr_ + 64 * j); } while (0)
#define P6_PROC(VX, VY, M) do { float ss_ = 0.f; \
        _Pragma("unroll") for (int j = 0; j < 8; ++j) { const float y0 = bf_lo(VY[j].x), y1 = bf_hi(VY[j].x), y2 = bf_lo(VY[j].y), y3 = bf_hi(VY[j].y); ss_ += (y0 * y0 + y1 * y1) + (y2 * y2 + y3 * y3); } \
        const float rstd_ = 1.0f / sqrtf(wave_sum(ss_) * (1.0f / DM) + EPS); float s2_ = 0.f; \
        _Pragma("unroll") for (int j = 0; j < 8; ++j) { \
            const f32x4 yv = {bf_lo(VY[j].x), bf_hi(VY[j].x), bf_lo(VY[j].y), bf_hi(VY[j].y)}; \
            VX[j] = VX[j] + A1[j] * (yv * rstd_); \
            s2_ += (VX[j].x * VX[j].x + VX[j].y * VX[j].y) + (VX[j].z * VX[j].z + VX[j].w * VX[j].w); } \
        const float rstd2_ = 1.0f / sqrtf(wave_sum(s2_) * (1.0f / DM) + EPS); u32x2* hr_ = (u32x2*)(H2 + (size_t)(M) * DM) + lane; \
        _Pragma("unroll") for (int j = 0; j < 8; ++j) { const f32x4 hv = (VX[j] * rstd2_) * A2[j] + B2[j]; \
            u32x2 w; w.x = cvt_pk_bf16(hv.x, hv.y); w.y = cvt_pk_bf16(hv.z, hv.w); hr_[64 * j] = w; } } while (0)
        for (int b = 0; b < NBATCH; ++b) {
            const float* mb = MOD + b * NMOD; const int mend = (b + 1) * SEQ;
            f32x4 A1[8], A2[8], B2[8];
#pragma unroll
            for (int j = 0; j < 8; ++j) { const int col = 4 * (lane + 64 * j);
                A1[j] = *(const f32x4*)(mb + 2 * DM + col) * *(const f32x4*)(gpost + col);
                A2[j] = *(const f32x4*)(gpre + col) * (*(const f32x4*)(mb + 4 * DM + col) + 1.0f); B2[j] = *(const f32x4*)(mb + 3 * DM + col); }
            f32x4 xa[8]; u32x2 ya[8];
            for (int m = b * SEQ + gw; m < mend; m += NGW) { P6_LOAD(xa, ya, m); P6_PROC(xa, ya, m); }
        }
#undef P6_LOAD
#undef P6_PROC
    }
    SEAM(6);

    for (int rep_ = 0; rep_ < NREP(7); ++rep_) if (IN(7)) {
        pg8::Gemm g{H2, WUP, DM, DM, DM, H2, WUP}; pg8::Order S; S.init(MTOK / 256, DUP / 256, G, bid, 0);
        pg8::EpiUp E{ACT, HALO, args.in[I_CONVW], args.in[I_CONVB]};
        pg8::gemm_phase<pg8::EpiUp, pg8::Order, true, true>(lds, g, S, E);
    }
    SEAM(7);

    for (int rep_ = 0; rep_ < NREP(8); ++rep_) if (IN(8)) {
        int tid = threadIdx.x; asm volatile("" : "+v"(tid)); const int lane = tid & 63; (void)lane;
        const float* cw = args.in[I_CONVW]; const float* cb = args.in[I_CONVB];
        constexpr int NC8 = DFF / 8;
        const int total = 512 * 2 * NC8;
        for (int it = bid * 512 + tid; it < total; it += G * 512) {
            const int cg8 = it % NC8, rs = it / NC8, side = rs & 1, k = rs >> 1;
            const int c0 = cg8 * 8, dcol = 256 * (c0 >> 7) + (c0 & 127);
            const bf16_t* hk = HALO + (size_t)k * 4 * DUP;
            u32x4 ma, mg, za, zg, pa, pg; const u32x4 zero = {0u, 0u, 0u, 0u};
            if (side == 0) {
                if ((k & 127) == 0) { ma = zero; mg = zero; } else { const bf16_t* hm = hk - 4 * DUP + 3 * DUP; ma = *(const u32x4*)(hm + dcol); mg = *(const u32x4*)(hm + dcol + 128); }
                za = *(const u32x4*)(hk + dcol); zg = *(const u32x4*)(hk + dcol + 128);
                pa = *(const u32x4*)(hk + DUP + dcol); pg = *(const u32x4*)(hk + DUP + dcol + 128);
            } else {
                ma = *(const u32x4*)(hk + 2 * DUP + dcol); mg = *(const u32x4*)(hk + 2 * DUP + dcol + 128);
                za = *(const u32x4*)(hk + 3 * DUP + dcol); zg = *(const u32x4*)(hk + 3 * DUP + dcol + 128);
                if ((k & 127) == 127) { pa = zero; pg = zero; } else { const bf16_t* hn = hk + 4 * DUP; pa = *(const u32x4*)(hn + dcol); pg = *(const u32x4*)(hn + dcol + 128); }
            }
            float res[8];
#pragma unroll
            for (int e = 0; e < 8; ++e) {
                const unsigned wm_a = ma[e >> 1], wz_a = za[e >> 1], wp_a = pa[e >> 1], wm_g = mg[e >> 1], wz_g = zg[e >> 1], wp_g = pg[e >> 1];
                const float am = (e & 1) ? bf_hi(wm_a) : bf_lo(wm_a), az = (e & 1) ? bf_hi(wz_a) : bf_lo(wz_a), ap = (e & 1) ? bf_hi(wp_a) : bf_lo(wp_a);
                const float gm = (e & 1) ? bf_hi(wm_g) : bf_lo(wm_g), gz = (e & 1) ? bf_hi(wz_g) : bf_lo(wz_g), gp = (e & 1) ? bf_hi(wp_g) : bf_lo(wp_g);
                const int ca = c0 + e, cgc = DFF + c0 + e;
                const float va = cb[ca] + cw[ca] * am + cw[DUP + ca] * az + cw[2 * DUP + ca] * ap;
                const float vg = cb[cgc] + cw[cgc] * gm + cw[DUP + cgc] * gz + cw[2 * DUP + cgc] * gp;
                res[e] = va * vg * sigmoidf_(vg);
            }
            u32x4 w; w.x = cvt_pk_bf16(res[0], res[1]); w.y = cvt_pk_bf16(res[2], res[3]); w.z = cvt_pk_bf16(res[4], res[5]); w.w = cvt_pk_bf16(res[6], res[7]);
            const int row = k * 64 + (side ? 63 : 0);
            *(u32x4*)(ACT + (size_t)row * DFF + c0) = w;
        }
    }
    SEAM(8);

    for (int rep_ = 0; rep_ < NREP(9); ++rep_) if (IN(9)) {
        pg8::Gemm g{ACT, WDN, DFF, DFF, DFF, ACT, WDN}; pg8::Order S; S.init(MTOK / 256, DM / 256, G, bid, 0);
        pg8::EpiBf16 E{F, DM};
        pg8::gemm_phase<pg8::EpiBf16, pg8::Order, true, true>(lds, g, S, E);
    }
    SEAM(9);

    for (int rep_ = 0; rep_ < NREP(10); ++rep_) if (IN(10)) {
        int tid = threadIdx.x; asm volatile("" : "+v"(tid)); const int lane = tid & 63; (void)lane;
        const float* gpost = args.in[I_GFPOST]; const float* gpost1 = args.in[I_GAPOST]; const float* x = args.in[I_X];
#define PA_LOAD(VX, VY, VF, M) do { const f32x4* xr_ = (const f32x4*)(x + (size_t)(M) * DM) + lane; const u32x2* yr_ = (const u32x2*)(Y + (size_t)(M) * DM) + lane; const u32x2* fr_ = (const u32x2*)(F + (size_t)(M) * DM) + lane; \
        _Pragma("unroll") for (int j = 0; j < 8; ++j) VY[j] = yr_[64 * j]; \
        _Pragma("unroll") for (int j = 0; j < 8; ++j) VF[j] = fr_[64 * j]; \
        _Pragma("unroll") for (int j = 0; j < 8; ++j) VX[j] = __builtin_nontemporal_load(xr_ + 64 * j); } while (0)
#define PA_PROC(VX, VY, VF, M) do { float ss_ = 0.f, sy_ = 0.f; \
        _Pragma("unroll") for (int j = 0; j < 8; ++j) { const float y0 = bf_lo(VY[j].x), y1 = bf_hi(VY[j].x), y2 = bf_lo(VY[j].y), y3 = bf_hi(VY[j].y); sy_ += (y0 * y0 + y1 * y1) + (y2 * y2 + y3 * y3); } \
        _Pragma("unroll") for (int j = 0; j < 8; ++j) { const float y0 = bf_lo(VF[j].x), y1 = bf_hi(VF[j].x), y2 = bf_lo(VF[j].y), y3 = bf_hi(VF[j].y); ss_ += (y0 * y0 + y1 * y1) + (y2 * y2 + y3 * y3); } \
        const float rstdy_ = 1.0f / sqrtf(wave_sum(sy_) * (1.0f / DM) + EPS); \
        const float rstd_ = 1.0f / sqrtf(wave_sum(ss_) * (1.0f / DM) + EPS); \
        f32x4* orow_ = (f32x4*)(args.out + (size_t)(M) * DM) + lane; \
        _Pragma("unroll") for (int j = 0; j < 8; ++j) { \
            const f32x4 yv = {bf_lo(VY[j].x), bf_hi(VY[j].x), bf_lo(VY[j].y), bf_hi(VY[j].y)}; \
            const f32x4 fv = {bf_lo(VF[j].x), bf_hi(VF[j].x), bf_lo(VF[j].y), bf_hi(VF[j].y)}; \
            const f32x4 x1 = VX[j] + A1[j] * (yv * rstdy_); \
            __builtin_nontemporal_store(x1 + A3[j] * (fv * rstd_), orow_ + 64 * j); } } while (0)
        for (int b = 0; b < NBATCH; ++b) {
            const float* mb = MOD + b * NMOD; const int mend = (b + 1) * SEQ;
            f32x4 A1[8], A3[8];
#pragma unroll
            for (int j = 0; j < 8; ++j) { const int col = 4 * (lane + 64 * j);
                A1[j] = *(const f32x4*)(mb + 2 * DM + col) * *(const f32x4*)(gpost1 + col);
                A3[j] = *(const f32x4*)(mb + 5 * DM + col) * *(const f32x4*)(gpost + col); }
            f32x4 xa[8]; u32x2 ya[8], fa[8];
            for (int m = b * SEQ + gw; m < mend; m += NGW) { PA_LOAD(xa, ya, fa, m); PA_PROC(xa, ya, fa, m); }
        }
#undef PA_LOAD
#undef PA_PROC
    }
#undef IN
#undef SEAM
}

extern "C" void kernel_launch(void* const* d_in, const int* in_sizes, int n_in, void* d_out, int out_size, void* d_ws, size_t ws_size, hipStream_t stream) {
    static int grid = 0;
    if (grid == 0) {
        if (n_in != 20 || in_sizes[0] != MTOK * DM || out_size != MTOK * DM || ws_size < WS_END) {
            fprintf(stderr, "kernel_launch: unexpected shapes: n_in %d in0 %d out %d ws %zu (need >= %zu)\n", n_in, n_in > 0 ? in_sizes[0] : -1, out_size, ws_size, (size_t)WS_END); grid = -1; return; }
        int dev = 0, cus = 0, per_cu = 0;
        if (hipGetDevice(&dev) != hipSuccess || hipDeviceGetAttribute(&cus, hipDeviceAttributeMultiprocessorCount, dev) != hipSuccess) { fprintf(stderr, "kernel_launch: device query failed\n"); grid = -1; return; }
        if (hipFuncSetAttribute((const void*)fwd_mega, hipFuncAttributeMaxDynamicSharedMemorySize, LDS_BYTES) != hipSuccess) { fprintf(stderr, "kernel_launch: hipFuncSetAttribute failed\n"); grid = -1; return; }
        if (hipOccupancyMaxActiveBlocksPerMultiprocessor(&per_cu, (const void*)fwd_mega, 512, LDS_BYTES) != hipSuccess || per_cu < 1) { fprintf(stderr, "kernel_launch: occupancy query says %d\n", per_cu); per_cu = 1; }
        (void)hipGetLastError();
        grid = cus * 1;
        if (grid != 256) fprintf(stderr, "kernel_launch: note: %d CUs\n", cus);
    }
    if (grid < 0) return;
    if (hipMemsetAsync(d_ws, 0, CTL_ZERO_BYTES, stream) != hipSuccess) { fprintf(stderr, "kernel_launch: memset failed\n"); return; }
    Args a{};
    for (int i = 0; i < 20; ++i) a.in[i] = (const float*)d_in[i];
    a.out = (float*)d_out; a.ws = (unsigned char*)d_ws;
#if MK_N_LAUNCHES == 1
    a.ph_lo = 0; a.ph_hi = NPHASE;
    void* kargs[] = {&a};
    hipError_t e = hipLaunchCooperativeKernel((const void*)fwd_mega, dim3(grid), dim3(512), kargs, LDS_BYTES, stream);
    if (e != hipSuccess) fprintf(stderr, "kernel_launch: cooperative launch failed: %s (grid %d)\n", hipGetErrorString(e), grid);
#else
    for (int p = 0; p < NPHASE; ++p) { a.ph_lo = p; a.ph_hi = p + 1;
        hipLaunchKernelGGL(fwd_mega, dim3(grid), dim3(512), LDS_BYTES, stream, a);
        const hipError_t le = hipPeekAtLastError(); if (le != hipSuccess) { fprintf(stderr, "kernel_launch: launch %d failed: %s\n", p, hipGetErrorName(le)); break; } }
#endif
}
```

```cpp
#include <hip/hip_runtime.h>
#include <hip/hip_cooperative_groups.h>
#include <cstdio>
#include <cstdint>
namespace cg = cooperative_groups;

#ifndef MK_N_LAUNCHES
#define MK_N_LAUNCHES 1
#endif

#define LAS __attribute__((address_space(3)))
typedef unsigned short bf16_t;
typedef short bf16x8 __attribute__((ext_vector_type(8)));
typedef short s16x4 __attribute__((ext_vector_type(4)));
typedef float f32x4 __attribute__((ext_vector_type(4)));
typedef float f32x2 __attribute__((ext_vector_type(2)));
typedef float f32x16 __attribute__((ext_vector_type(16)));
typedef unsigned u32x4 __attribute__((ext_vector_type(4)));
typedef unsigned u32x2 __attribute__((ext_vector_type(2)));

constexpr int DM = 2048, NBATCH = 4, SEQ = 8192, CTXL = 256;
constexpr int MTOK = NBATCH * SEQ;
constexpr int MCTX = NBATCH * CTXL;
constexpr int MALL = MTOK + MCTX;
constexpr int DIN = 8704, DFF = 5632, DUP = 2 * DFF;
constexpr int C_QA = 0, C_KA = 1024, C_VA = 1280, C_QB = 1536, C_KB = 2560, C_VB = 3584, C_GA = 4608, C_GB = 6656;
constexpr int NMOD = 6 * DM;
constexpr float EPS = 1e-6f;
constexpr float LOG2E = 1.4426950408889634f;
constexpr float QSCALE = 0.08838834764831845f * LOG2E;
constexpr float NEGBIG = -1e30f;

constexpr size_t MiB = 1u << 20;
constexpr size_t WS_BAR = 16384, CTL_ZERO_BYTES = 64 * 1024;
constexpr size_t WS_MOD = 64 * 1024;
constexpr size_t WS_ROPEC = 512 * 1024;
constexpr size_t WS_ROPES = 768 * 1024;
constexpr size_t WS_WIN = 4 * MiB;
constexpr size_t WS_WBA = 38 * MiB;
constexpr size_t WS_WBB = 42 * MiB;
constexpr size_t WS_WO = 46 * MiB;
constexpr size_t WS_WUP = 54 * MiB;
constexpr size_t WS_WDN = 98 * MiB;
constexpr size_t WS_H = 120 * MiB;
constexpr size_t WS_OAB = 252 * MiB;
constexpr size_t WS_QKVG = 380 * MiB;
constexpr size_t WS_Y = 380 * MiB;
constexpr size_t WS_ACT = 508 * MiB;
constexpr size_t WS_HALO = 860 * MiB;
constexpr size_t WS_END = 941 * MiB;

constexpr int LDS_BYTES = 147456;

__device__ __forceinline__ unsigned cvt_pk_bf16(float lo, float hi) { unsigned r; asm volatile("v_cvt_pk_bf16_f32 %0, %1, %2" : "=v"(r) : "v"(lo), "v"(hi)); return r; }
__device__ __forceinline__ float bf_lo(unsigned w) { return __uint_as_float(w << 16); }
__device__ __forceinline__ float bf_hi(unsigned w) { return __uint_as_float(w & 0xffff0000u); }
__device__ __forceinline__ float wave_sum(float v) {
#pragma unroll
    for (int o = 1; o < 64; o <<= 1) v += __shfl_xor(v, o);
    return v;
}
__device__ __forceinline__ float sigmoidf_(float x) { return __builtin_amdgcn_rcpf(1.0f + __builtin_amdgcn_exp2f(-x * LOG2E)); }
template <int CTRL> __device__ __forceinline__ float dppf(float old, float src) {
    return __int_as_float(__builtin_amdgcn_update_dpp(__float_as_int(old), __float_as_int(src), CTRL, 0xf, 0xf, false));
}


#define XB_TMO      128
#define XB_XCNT(j)  (256  + 64 * (j))
#define XB_XSUB(j)  (1280 + 64 * (j))
#define XB_XGEN(j)  (2304 + 64 * (j))
#define XB_TOP      3328
#define XB_TOPGEN   3392
#define XCD_BAR_WORDS 3456
#define XB_SPIN_CAP (1u << 18)
__device__ __forceinline__ unsigned xb_ld(unsigned* p)              { return __hip_atomic_load(p, __ATOMIC_RELAXED, __HIP_MEMORY_SCOPE_AGENT); }
__device__ __forceinline__ unsigned xb_add(unsigned* p, unsigned v) { return __hip_atomic_fetch_add(p, v, __ATOMIC_RELAXED, __HIP_MEMORY_SCOPE_AGENT); }
__device__ __forceinline__ unsigned xb_xcc_id() { return (unsigned)__builtin_amdgcn_s_getreg((3 << 11) | 20) & 0xFu; }
#define XB_SPIN(cond, bar) do { unsigned _sp = 0; while (cond) { __builtin_amdgcn_s_sleep(1); \
    if ((++_sp & 255u) == 0u) { if (xb_ld(&(bar)[XB_TMO])) break; if (_sp > XB_SPIN_CAP) { atomicAdd(&(bar)[XB_TMO], 1u); break; } } } } while (0)
struct XcdBarrier { unsigned* bar; unsigned x; volatile LAS unsigned* st; };
__device__ __forceinline__ XcdBarrier xcd_barrier_post(unsigned* bar, volatile LAS unsigned* st) {
    XcdBarrier b; b.bar = bar; b.x = xb_xcc_id(); b.st = st;
    if (threadIdx.x == 0) (void)xb_add(&bar[XB_XCNT(b.x)], 1u);
    return b;
}
__device__ __forceinline__ void xcd_barrier_complete(unsigned* bar, unsigned x, unsigned& nloc, unsigned& nx) {
    const unsigned G = gridDim.x * gridDim.y * gridDim.z;
    unsigned sum, cnt, mine, sp = 0u;
    for (;;) {
        sum = 0u; cnt = 0u; mine = 0u;
#pragma unroll
        for (unsigned j = 0; j < 16; ++j) { const unsigned c = xb_ld(&bar[XB_XCNT(j)]); sum += c; cnt += (c > 0u) ? 1u : 0u; mine = (j == x) ? c : mine; }
        if (sum == G) break;
        __builtin_amdgcn_s_sleep(1);
        if ((++sp & 255u) == 0u) { if (xb_ld(&bar[XB_TMO])) break; if (sp > XB_SPIN_CAP) { atomicAdd(&bar[XB_TMO], 1u); break; } }
    }
    nloc = mine > 0u ? mine : 1u; nx = cnt > 0u ? cnt : 1u;
}
__device__ __forceinline__ void xcd_barrier(const XcdBarrier& b) {
    asm volatile("s_waitcnt vmcnt(0)" ::: "memory");
    __syncthreads();
    if (threadIdx.x == 0) {
        unsigned* bar = b.bar;
        __builtin_amdgcn_s_waitcnt(0);
        unsigned nloc = b.st[0], nx = b.st[1];
        if (nloc == 0u) { xcd_barrier_complete(bar, b.x, nloc, nx); b.st[0] = nloc; b.st[1] = nx; }
        const unsigned old = xb_add(&bar[XB_XSUB(b.x)], 1u);
        const unsigned gen = old / nloc;
        if (old + 1u == (gen + 1u) * nloc) {
            __builtin_amdgcn_fence(__ATOMIC_RELEASE, "agent");
            asm volatile("s_waitcnt vmcnt(0)" ::: "memory");
            const unsigned og = xb_add(&bar[XB_TOP], 1u);
            const unsigned tg = og / nx;
            if (og + 1u == (tg + 1u) * nx) xb_add(&bar[XB_TOPGEN], 1u);
            else XB_SPIN(xb_ld(&bar[XB_TOPGEN]) == tg, bar);
            __builtin_amdgcn_fence(__ATOMIC_ACQUIRE, "agent");
            xb_add(&bar[XB_XGEN(b.x)], 1u);
            asm volatile("s_waitcnt vmcnt(0)" ::: "memory");
        } else {
            XB_SPIN(xb_ld(&bar[XB_XGEN(b.x)]) == gen, bar);
            __builtin_amdgcn_fence(__ATOMIC_ACQUIRE, "agent");
            asm volatile("s_waitcnt vmcnt(0)" ::: "memory");
        }
    }
    __syncthreads();
}

namespace pg8 {
constexpr int BM = 256, BK = 64, HALF = 128, HTB = HALF * BK * 2, STAGE_BYTES = 8 * HTB, NXCD = 8, WGM = 8;
__host__ __device__ __forceinline__ int lds_byte(int r, int c) { const int st = (r >> 4) * 2 + (c >> 5), rr = r & 15, cc = c & 31, ob = rr * 64 + cc * 2; return st * 1024 + (ob ^ (((ob >> 9) & 1) << 5)); }
__host__ __device__ __forceinline__ void stage_rc(int b, int& R, int& C) { const int st = b / 1024, sb = b % 1024, swz = sb ^ (((sb >> 9) & 1) << 5); R = (st >> 1) * 16 + swz / 64; C = (st & 1) * 32 + (swz % 64) / 2; }
__host__ __device__ __forceinline__ int perm32(int rho) { const int n = rho >> 4, i = rho & 15; return 8 * (i >> 2) + 4 * n + (i & 3); }

struct Unit { int pm, pn, seg; };
struct Gemm { const bf16_t* A; const bf16_t* Bt; int lda, ldb, K; const bf16_t* A2; const bf16_t* Bt2; };

struct Order {
    int nM, nN, nwg, G, c, extra, twoseg;
    __device__ void init(int nM_, int nN_, int G_, int c_, int extra_, int twoseg_ = 0) { nM = nM_; nN = nN_; nwg = nM * nN; G = G_; c = c_; extra = extra_; twoseg = twoseg_; }
    __device__ bool next(int i, Unit& u) const {
        u.seg = twoseg ? (i & 1) : 0; if (twoseg) i >>= 1;
        const long L = (long)i * G + c; if (L >= nwg + extra) return false;
        if (L >= nwg) { const int idx = (int)L - nwg, k = idx % 10; u.pm = 128 + idx / 10; u.pn = k < 2 ? 4 + k : 8 + k; return true; }
        int wgid = (int)L; { const int q = nwg / NXCD, r = nwg % NXCD, xcd = wgid % NXCD, off = wgid / NXCD; wgid = (xcd < r ? xcd * (q + 1) : r * (q + 1) + (xcd - r) * q) + off; }
        const int nig = WGM * nN, gid = wgid / nig, fm = gid * WGM, gsz = (nM - fm) < WGM ? (nM - fm) : WGM;
        u.pm = fm + ((wgid % nig) % gsz); u.pn = (wgid % nig) / gsz; return true;
    }
};

typedef f32x4 Acc[2][2][4][2];

struct EpiBf16 {
    static constexpr bool PERM = true;
    __device__ __forceinline__ static bool keep_acc(const Unit&) { return false; }
    bf16_t* O; int ldc;
    __device__ __forceinline__ void operator()(Acc& acc, const Unit& u, int wr, int wc, int fr, int fq) const {
        const int row0 = u.pm * BM + wr * 64 + fr, col0 = u.pn * BM + wc * 32 + 8 * fq;
#pragma unroll
        for (int ai = 0; ai < 2; ++ai)
#pragma unroll
            for (int m = 0; m < 4; ++m) { bf16_t* rowp = O + (size_t)(row0 + ai * HALF + m * 16) * ldc + col0;
#pragma unroll
                for (int bj = 0; bj < 2; ++bj) { const f32x4 v0 = acc[ai][bj][m][0], v1 = acc[ai][bj][m][1];
                    u32x4 w; w.x = cvt_pk_bf16(v0[0], v0[1]); w.y = cvt_pk_bf16(v0[2], v0[3]); w.z = cvt_pk_bf16(v1[0], v1[1]); w.w = cvt_pk_bf16(v1[2], v1[3]);
                    *(u32x4*)(rowp + bj * HALF) = w; } }
    }
};

struct EpiQKV {
    static constexpr bool PERM = true;
    __device__ __forceinline__ static bool keep_acc(const Unit&) { return false; }
    bf16_t* O; const float* rc; const float* rs;
    __device__ __forceinline__ void operator()(Acc& acc, const Unit& u, int wr, int wc, int fr, int fq) const {
        const int pn = u.pn; int mode = 0;
        if (pn <= 4) mode = (u.pm < 128) ? 1 : 0; else if (pn >= 6 && pn <= 9) mode = 2; else if (pn >= 18) mode = 3;
        const float qs = (pn < 4 || mode == 2) ? QSCALE : 1.0f;
        const int row0 = u.pm * BM + wr * 64 + fr, col0 = pn * BM + wc * 32 + 8 * fq;
        const int ridx = 16 * (wc & 1) + 4 * fq;
        f32x4 cq[2][4], sq[2][4];
#pragma unroll
        for (int ai = 0; ai < 2; ++ai)
#pragma unroll
            for (int m = 0; m < 4; ++m) { cq[ai][m] = (f32x4){1.f, 1.f, 1.f, 1.f}; sq[ai][m] = (f32x4){0.f, 0.f, 0.f, 0.f};
                if (mode == 1) { const int t = (row0 + ai * HALF + m * 16) & (SEQ - 1); const int pos = (wc >> 1) ? (t & 63) : (t >> 6); cq[ai][m] = *(const f32x4*)(rc + pos * 32 + ridx); sq[ai][m] = *(const f32x4*)(rs + pos * 32 + ridx); } }
#pragma unroll
        for (int ai = 0; ai < 2; ++ai)
#pragma unroll
            for (int m = 0; m < 4; ++m) { const int row = row0 + ai * HALF + m * 16; bf16_t* rowp = O + (size_t)row * DIN + col0;
                const f32x4 c4 = cq[ai][m], s4 = sq[ai][m];
#pragma unroll
                for (int bj = 0; bj < 2; ++bj) { f32x4 v0 = acc[ai][bj][m][0], v1 = acc[ai][bj][m][1];
                    if (mode == 1) { const f32x4 o0 = v0 * c4 - v1 * s4, o1 = v1 * c4 + v0 * s4; v0 = o0 * qs; v1 = o1 * qs; }
                    else if (mode == 2) { v0 = v0 * qs; v1 = v1 * qs; }
                    else if (mode == 3) {
#pragma unroll
                        for (int e = 0; e < 4; ++e) { v0[e] = sigmoidf_(v0[e]); v1[e] = sigmoidf_(v1[e]); } }
                    u32x4 w; w.x = cvt_pk_bf16(v0[0], v0[1]); w.y = cvt_pk_bf16(v0[2], v0[3]); w.z = cvt_pk_bf16(v1[0], v1[1]); w.w = cvt_pk_bf16(v1[2], v1[3]);
                    *(u32x4*)(rowp + bj * HALF) = w; } }
    }
};

struct EpiBranch2 {
    static constexpr bool PERM = true;
    __device__ __forceinline__ static bool keep_acc(const Unit& u) { return u.seg == 0; }
    bf16_t* Z; const bf16_t* GA; const bf16_t* GB;
    __device__ __forceinline__ void operator()(Acc& acc, const Unit& u, int wr, int wc, int fr, int fq) const {
        const int row0 = u.pm * BM + wr * 64 + fr, col0 = u.pn * BM + wc * 32 + 8 * fq;
        if (u.seg == 0) {
#pragma unroll
            for (int ai = 0; ai < 2; ++ai)
#pragma unroll
                for (int m = 0; m < 4; ++m) { const size_t ro = (size_t)(row0 + ai * HALF + m * 16) * DIN + col0;
#pragma unroll
                    for (int bj = 0; bj < 2; ++bj) { const u32x4 ga = *(const u32x4*)(GA + ro + bj * HALF), gb = *(const u32x4*)(GB + ro + bj * HALF);
                        f32x4 r0, r1;
                        r0[0] = bf_lo(ga.x) * __builtin_amdgcn_rcpf(fmaxf(bf_lo(gb.x), 1e-20f)); r0[1] = bf_hi(ga.x) * __builtin_amdgcn_rcpf(fmaxf(bf_hi(gb.x), 1e-20f));
                        r0[2] = bf_lo(ga.y) * __builtin_amdgcn_rcpf(fmaxf(bf_lo(gb.y), 1e-20f)); r0[3] = bf_hi(ga.y) * __builtin_amdgcn_rcpf(fmaxf(bf_hi(gb.y), 1e-20f));
                        r1[0] = bf_lo(ga.z) * __builtin_amdgcn_rcpf(fmaxf(bf_lo(gb.z), 1e-20f)); r1[1] = bf_hi(ga.z) * __builtin_amdgcn_rcpf(fmaxf(bf_hi(gb.z), 1e-20f));
                        r1[2] = bf_lo(ga.w) * __builtin_amdgcn_rcpf(fmaxf(bf_lo(gb.w), 1e-20f)); r1[3] = bf_hi(ga.w) * __builtin_amdgcn_rcpf(fmaxf(bf_hi(gb.w), 1e-20f));
                        acc[ai][bj][m][0] *= r0; acc[ai][bj][m][1] *= r1; } }
        } else {
            u32x4 gq[2][4][2];
#pragma unroll
            for (int ai = 0; ai < 2; ++ai)
#pragma unroll
                for (int m = 0; m < 4; ++m)
#pragma unroll
                    for (int bj = 0; bj < 2; ++bj) gq[ai][m][bj] = *(const u32x4*)(GB + (size_t)(row0 + ai * HALF + m * 16) * DIN + col0 + bj * HALF);
#pragma unroll
            for (int ai = 0; ai < 2; ++ai)
#pragma unroll
                for (int m = 0; m < 4; ++m) { const int row = row0 + ai * HALF + m * 16; bf16_t* zp = Z + (size_t)row * DM + col0;
#pragma unroll
                    for (int bj = 0; bj < 2; ++bj) { f32x4 v0 = acc[ai][bj][m][0], v1 = acc[ai][bj][m][1];
                        const u32x4 g = gq[ai][m][bj];
                        v0[0] *= fmaxf(bf_lo(g.x), 1e-20f); v0[1] *= fmaxf(bf_hi(g.x), 1e-20f); v0[2] *= fmaxf(bf_lo(g.y), 1e-20f); v0[3] *= fmaxf(bf_hi(g.y), 1e-20f);
                        v1[0] *= fmaxf(bf_lo(g.z), 1e-20f); v1[1] *= fmaxf(bf_hi(g.z), 1e-20f); v1[2] *= fmaxf(bf_lo(g.w), 1e-20f); v1[3] *= fmaxf(bf_hi(g.w), 1e-20f);
                        u32x4 w; w.x = cvt_pk_bf16(v0[0], v0[1]); w.y = cvt_pk_bf16(v0[2], v0[3]); w.z = cvt_pk_bf16(v1[0], v1[1]); w.w = cvt_pk_bf16(v1[2], v1[3]);
                        *(u32x4*)(zp + bj * HALF) = w; } }
        }
    }
};

struct EpiUp {
    static constexpr bool PERM = true;
    __device__ __forceinline__ static bool keep_acc(const Unit&) { return false; }
    bf16_t* ACT; bf16_t* HALO; const float* cw; const float* cb;
    __device__ __forceinline__ void operator()(Acc& acc, const Unit& u, int wr, int wc, int fr, int fq) const {
        const int cc = wc * 32 + 8 * fq, acol = u.pn * HALF + cc;
        f32x4 cwa[2][4], cwg[2][4];
#pragma unroll
        for (int n = 0; n < 2; ++n) { const int ca = acol + 4 * n, cg_ = DFF + acol + 4 * n;
            cwa[n][0] = *(const f32x4*)(cw + ca); cwa[n][1] = *(const f32x4*)(cw + DUP + ca); cwa[n][2] = *(const f32x4*)(cw + 2 * DUP + ca); cwa[n][3] = *(const f32x4*)(cb + ca);
            cwg[n][0] = *(const f32x4*)(cw + cg_); cwg[n][1] = *(const f32x4*)(cw + DUP + cg_); cwg[n][2] = *(const f32x4*)(cw + 2 * DUP + cg_); cwg[n][3] = *(const f32x4*)(cb + cg_); }
#pragma unroll
        for (int ai = 0; ai < 2; ++ai) { const int chunk = u.pm * 4 + ai * 2 + wr;
            if (fr < 2 || fr >= 14) { const int slot = fr < 2 ? fr : fr - 12;
                bf16_t* hp = HALO + ((size_t)(chunk * 4 + slot) * DUP + u.pn * BM + cc);
#pragma unroll
                for (int bj = 0; bj < 2; ++bj) { const f32x4 v0 = fr < 2 ? acc[ai][bj][0][0] : acc[ai][bj][3][0], v1 = fr < 2 ? acc[ai][bj][0][1] : acc[ai][bj][3][1];
                    u32x4 w; w.x = cvt_pk_bf16(v0[0], v0[1]); w.y = cvt_pk_bf16(v0[2], v0[3]); w.z = cvt_pk_bf16(v1[0], v1[1]); w.w = cvt_pk_bf16(v1[2], v1[3]);
                    *(u32x4*)(hp + bj * HALF) = w; } } }
#pragma unroll
        for (int n = 0; n < 2; ++n) {
            const f32x4 wa0 = cwa[n][0], wa1 = cwa[n][1], wa2 = cwa[n][2], ba = cwa[n][3];
            const f32x4 wg0 = cwg[n][0], wg1 = cwg[n][1], wg2 = cwg[n][2], bg = cwg[n][3];
#pragma unroll
            for (int k = 0; k < 4; ++k)
#pragma unroll
                for (int ai = 0; ai < 2; ++ai) {
                    float ra[4], rg[4], pa[4], pg[4], na[4], ng[4];
#pragma unroll
                    for (int m = 0; m < 4; ++m) { ra[m] = acc[ai][0][m][n][k]; rg[m] = acc[ai][1][m][n][k]; }
#pragma unroll
                    for (int m = 0; m < 4; ++m) {
                        const float oa = m > 0 ? dppf<0x121>(ra[m - 1], ra[m - 1]) : 0.f, og = m > 0 ? dppf<0x121>(rg[m - 1], rg[m - 1]) : 0.f;
                        pa[m] = dppf<0x111>(oa, ra[m]); pg[m] = dppf<0x111>(og, rg[m]);
                        const float qa = m < 3 ? dppf<0x12F>(ra[m + 1], ra[m + 1]) : 0.f, qg = m < 3 ? dppf<0x12F>(rg[m + 1], rg[m + 1]) : 0.f;
                        na[m] = dppf<0x101>(qa, ra[m]); ng[m] = dppf<0x101>(qg, rg[m]);
                    }
#pragma unroll
                    for (int m = 0; m < 4; ++m) {
                        const float va = ba[k] + wa0[k] * pa[m] + wa1[k] * ra[m] + wa2[k] * na[m];
                        const float vg = bg[k] + wg0[k] * pg[m] + wg1[k] * rg[m] + wg2[k] * ng[m];
                        acc[ai][0][m][n][k] = va * vg * sigmoidf_(vg);
                    }
                }
        }
        const int row0 = u.pm * BM + wr * 64 + fr;
#pragma unroll
        for (int ai = 0; ai < 2; ++ai)
#pragma unroll
            for (int m = 0; m < 4; ++m) { const f32x4 v0 = acc[ai][0][m][0], v1 = acc[ai][0][m][1];
                u32x4 w; w.x = cvt_pk_bf16(v0[0], v0[1]); w.y = cvt_pk_bf16(v0[2], v0[3]); w.z = cvt_pk_bf16(v1[0], v1[1]); w.w = cvt_pk_bf16(v1[2], v1[3]);
                *(u32x4*)(ACT + (size_t)(row0 + ai * HALF + m * 16) * DFF + acol) = w; }
    }
};

template <class Epi, class Sched, bool ALIGN_EPI, bool SP2>
__device__ __forceinline__ void gemm_phase(LAS unsigned char* lds, const Gemm g, const Sched& S, const Epi& E) {
    int tid = threadIdx.x; asm volatile("" : "+v"(tid));
    const int wid = __builtin_amdgcn_readfirstlane(tid >> 6), lane = tid & 63, wr = wid >> 2, wc = wid & 3, fr = lane & 15, fq = lane >> 4;
    const int K = g.K, nt = K / BK;
    unsigned voffA[2], voffB[2];
#pragma unroll
    for (int i = 0; i < 2; ++i) { int R, C; stage_rc(tid * 16 + i * 8192, R, C); const int Rb = Epi::PERM ? ((R & ~31) + perm32(R & 31)) : R;
        voffA[i] = (unsigned)(R * g.lda + C) * 2u; voffB[i] = (unsigned)(Rb * g.ldb + C) * 2u; }
    const size_t kstep = (size_t)(BK * 2);
    const size_t hA = (size_t)HALF * g.lda * 2, hB = (size_t)HALF * g.ldb * 2;
    const size_t tA = 2 * hA, tB = 2 * hB;
    const unsigned ldsw = (unsigned)wid * 1024u;
    const int aoff = lds_byte(wr * 64 + fr, fq * 8), boff = lds_byte(wc * 32 + fr, fq * 8);
#define PG8_SA(b, h) (((b) * 2 + (h)) * HTB)
#define PG8_SB(b, h) ((4 + (b) * 2 + (h)) * HTB)
#define PG8_STAGE(bufoff, gbase, voff) do { _Pragma("unroll") for (int _i = 0; _i < 2; ++_i) \
        __builtin_amdgcn_global_load_lds((const unsigned*)((const char*)(gbase) + (voff)[_i]), (LAS unsigned*)(lds + (bufoff) + ldsw + _i * 8192), 16, 0, 0); } while (0)
#define PG8_LDA(dst, b, h) do { _Pragma("unroll") for (int m = 0; m < 4; ++m) _Pragma("unroll") for (int k = 0; k < 2; ++k) dst[m][k] = *(const LAS bf16x8*)(lds + PG8_SA(b, h) + aoff + m * 2048 + k * 1024); } while (0)
#define PG8_LDB(dst, b, h) do { _Pragma("unroll") for (int n = 0; n < 2; ++n) _Pragma("unroll") for (int k = 0; k < 2; ++k) dst[n][k] = *(const LAS bf16x8*)(lds + PG8_SB(b, h) + boff + n * 2048 + k * 1024); } while (0)
#define PG8_MMA(ai, bj, At, Bt) do { __builtin_amdgcn_s_setprio(1); _Pragma("unroll") for (int m = 0; m < 4; ++m) _Pragma("unroll") for (int n = 0; n < 2; ++n) _Pragma("unroll") for (int k = 0; k < 2; ++k) \
        acc[ai][bj][m][n] = __builtin_amdgcn_mfma_f32_16x16x32_bf16(Bt[n][k], At[m][k], acc[ai][bj][m][n], 0, 0, 0); __builtin_amdgcn_s_setprio(0); } while (0)
#define PG8_WAIT_V(n) asm volatile("s_waitcnt vmcnt(" #n ")" ::: "memory")
#define PG8_WAIT_L(n) asm volatile("s_waitcnt lgkmcnt(" #n ")" ::: "memory")
#define PG8_BAR __builtin_amdgcn_s_barrier()
#define PG8_SCHED __builtin_amdgcn_sched_barrier(0)
    Unit cur, nxt; int ui = 0;
    if (!S.next(0, cur)) return;
    Acc acc;
#pragma unroll
    for (int a = 0; a < 2; ++a)
#pragma unroll
        for (int b = 0; b < 2; ++b)
#pragma unroll
            for (int m = 0; m < 4; ++m)
#pragma unroll
                for (int n = 0; n < 2; ++n) acc[a][b][m][n] = (f32x4){0.f, 0.f, 0.f, 0.f};
    bf16x8 At[4][2], B0[2][2], B1[2][2];
    const char* cA = (const char*)(cur.seg ? g.A2 : g.A) + (size_t)cur.pm * tA; const char* cB = (const char*)(cur.seg ? g.Bt2 : g.Bt) + (size_t)cur.pn * tB;
    if constexpr (SP2) {
        PG8_STAGE(PG8_SB(0, 0), cB, voffB); PG8_STAGE(PG8_SB(0, 1), cB + hB, voffB); PG8_STAGE(PG8_SA(0, 0), cA, voffA); PG8_STAGE(PG8_SA(0, 1), cA + hA, voffA);
        if (wr == 1) PG8_BAR;
        PG8_WAIT_V(2); PG8_BAR;
        PG8_STAGE(PG8_SB(1, 0), cB + kstep, voffB); PG8_STAGE(PG8_SA(1, 0), cA + kstep, voffA); PG8_STAGE(PG8_SB(1, 1), cB + hB + kstep, voffB);
        PG8_WAIT_V(6); PG8_BAR;
    } else {
        PG8_STAGE(PG8_SB(0, 0), cB, voffB); PG8_STAGE(PG8_SA(0, 0), cA, voffA); PG8_STAGE(PG8_SB(0, 1), cB + hB, voffB); PG8_STAGE(PG8_SA(0, 1), cA + hA, voffA);
        if (wr == 1) PG8_BAR;
        PG8_WAIT_V(4); PG8_BAR;
        PG8_STAGE(PG8_SB(1, 0), cB + kstep, voffB); PG8_STAGE(PG8_SA(1, 0), cA + kstep, voffA); PG8_STAGE(PG8_SB(1, 1), cB + hB + kstep, voffB);
        PG8_WAIT_V(6); PG8_BAR;
    }
    for (;;) {
        const bool has_next = S.next(ui + 1, nxt);
        const char* nA = has_next ? (const char*)(nxt.seg ? g.A2 : g.A) + (size_t)nxt.pm * tA : cA; const char* nB = has_next ? (const char*)(nxt.seg ? g.Bt2 : g.Bt) + (size_t)nxt.pn * tB : cB;
        for (int t = 0; t < nt; t += 2) {
            const bool last = (t == nt - 2);
            const char* a1 = cA + (size_t)(t + 1) * kstep;
            const char* a2 = last ? nA : cA + (size_t)(t + 2) * kstep; const char* b2 = last ? nB : cB + (size_t)(t + 2) * kstep;
            const char* a3 = a2 + kstep; const char* b3 = b2 + kstep;
            if constexpr (SP2) {
            PG8_LDB(B0, 0, 0); PG8_LDB(B1, 0, 1); PG8_SCHED; PG8_LDA(At, 0, 0); PG8_STAGE(PG8_SA(1, 1), a1 + hA, voffA);
            PG8_WAIT_V(8); PG8_WAIT_L(0); PG8_BAR; PG8_MMA(0, 0, At, B0); PG8_MMA(0, 1, At, B1); PG8_BAR; PG8_SCHED;
            PG8_LDA(At, 0, 1); PG8_STAGE(PG8_SB(0, 0), b2, voffB); PG8_STAGE(PG8_SB(0, 1), b2 + hB, voffB); PG8_STAGE(PG8_SA(0, 0), a2, voffA);
            PG8_WAIT_V(8); PG8_WAIT_L(0); PG8_BAR; PG8_MMA(1, 0, At, B0); PG8_MMA(1, 1, At, B1); PG8_BAR; PG8_SCHED;
            PG8_LDB(B0, 1, 0); PG8_LDB(B1, 1, 1); PG8_SCHED; PG8_LDA(At, 1, 0); PG8_STAGE(PG8_SA(0, 1), a2 + hA, voffA);
            PG8_WAIT_V(8); PG8_WAIT_L(0); PG8_BAR; PG8_MMA(0, 0, At, B0); PG8_MMA(0, 1, At, B1); PG8_BAR; PG8_SCHED;
            PG8_LDA(At, 1, 1); PG8_STAGE(PG8_SB(1, 0), b3, voffB); PG8_STAGE(PG8_SB(1, 1), b3 + hB, voffB); PG8_STAGE(PG8_SA(1, 0), a3, voffA);
            PG8_WAIT_V(8); PG8_WAIT_L(0); PG8_BAR; PG8_MMA(1, 0, At, B0); PG8_MMA(1, 1, At, B1); PG8_BAR; PG8_SCHED;
            } else {
            PG8_LDB(B0, 0, 0); PG8_SCHED; PG8_LDA(At, 0, 0); PG8_STAGE(PG8_SA(1, 1), a1 + hA, voffA);
            PG8_WAIT_L(8); PG8_BAR; PG8_WAIT_L(0); PG8_MMA(0, 0, At, B0); PG8_BAR; PG8_SCHED;
            PG8_LDB(B1, 0, 1); PG8_STAGE(PG8_SB(0, 0), b2, voffB);
            PG8_BAR; PG8_WAIT_L(0); PG8_MMA(0, 1, At, B1); PG8_BAR;
            PG8_LDA(At, 0, 1); PG8_STAGE(PG8_SA(0, 0), a2, voffA);
            PG8_BAR; PG8_WAIT_L(0); PG8_MMA(1, 0, At, B0); PG8_BAR; PG8_SCHED;
            PG8_STAGE(PG8_SB(0, 1), b2 + hB, voffB);
            PG8_WAIT_V(6); PG8_BAR; PG8_MMA(1, 1, At, B1); PG8_BAR;
            PG8_LDB(B0, 1, 0); PG8_SCHED; PG8_LDA(At, 1, 0); PG8_STAGE(PG8_SA(0, 1), a2 + hA, voffA);
            PG8_WAIT_L(8); PG8_BAR; PG8_WAIT_L(0); PG8_MMA(0, 0, At, B0); PG8_BAR; PG8_SCHED;
            PG8_LDB(B1, 1, 1); PG8_STAGE(PG8_SB(1, 0), b3, voffB);
            PG8_BAR; PG8_WAIT_L(0); PG8_MMA(0, 1, At, B1); PG8_BAR;
            PG8_LDA(At, 1, 1); PG8_STAGE(PG8_SA(1, 0), a3, voffA);
            PG8_BAR; PG8_WAIT_L(0); PG8_MMA(1, 0, At, B0); PG8_BAR; PG8_SCHED;
            PG8_STAGE(PG8_SB(1, 1), b3 + hB, voffB);
            PG8_WAIT_V(6); PG8_BAR; PG8_MMA(1, 1, At, B1); PG8_BAR;
            }
        }
        if constexpr (ALIGN_EPI) { if (wr == 0) PG8_BAR; }
        E(acc, cur, wr, wc, fr, fq);
        if (!has_next) break;
        if (!Epi::keep_acc(cur))
#pragma unroll
        for (int a = 0; a < 2; ++a)
#pragma unroll
            for (int b = 0; b < 2; ++b)
#pragma unroll
                for (int m = 0; m < 4; ++m)
#pragma unroll
                    for (int n = 0; n < 2; ++n) acc[a][b][m][n] = (f32x4){0.f, 0.f, 0.f, 0.f};
        cur = nxt; cA = nA; cB = nB; ++ui;
        if constexpr (ALIGN_EPI) { if (wr == 1) PG8_BAR; }
    }
    PG8_WAIT_V(0);
    if constexpr (!ALIGN_EPI) { if (wr == 0) PG8_BAR; }
    PG8_BAR;
#undef PG8_SA
#undef PG8_SB
#undef PG8_STAGE
#undef PG8_LDA
#undef PG8_LDB
#undef PG8_MMA
#undef PG8_WAIT_V
#undef PG8_WAIT_L
#undef PG8_BAR
#undef PG8_SCHED
}
}

namespace att {
constexpr int SHM_V = 16384, SHM_K = 16384;
constexpr int OFF_V = 0, OFF_K = 3 * SHM_V, OFF_WS = OFF_K + 3 * SHM_K, OFF_TBL = OFF_WS + 8 * 256 + 1024;
#define KSWZ(row, colB) ((row) * 256 + ((colB) ^ (((row) & 7) << 4)))
#define SBAR() __builtin_amdgcn_sched_barrier(0)
__device__ __forceinline__ int crow(int r, int hi) { return (r & 3) + 8 * (r >> 2) + 4 * hi; }
__device__ __forceinline__ int v_st(int k, int c) { const int kk = (k & ~0xC) | ((k & 4) << 1) | ((k & 8) >> 1); return ((kk >> 3) * 4 + (c >> 5)) * 512 + ((kk & 7) * 32 + (c & 31)) * 2; }
__device__ __forceinline__ int v_rd_base(int lane) { return ((lane & 3) << 3) | (((lane >> 2) & 3) << 6) | (((lane >> 4) & 1) << 5) | (((lane >> 5) & 1) << 8); }
constexpr int v_rd_off(int d0, int ks, int half) { return d0 * 512 + ks * 4096 + half * 2048; }
template <int OFF> __device__ __forceinline__ s16x4 tr_read(int vb) {
    s16x4 r; asm volatile("ds_read_b64_tr_b16 %0, %1 offset:%2" : "=&v"(r) : "v"(vb), "i"(OFF) : "memory"); return r;
}
#define PK(L, H) (bf16x8){L[0], L[1], L[2], L[3], H[0], H[1], H[2], H[3]}
struct VFrag { s16x4 l0, h0, l1, h1, l2, h2, l3, h3; };
template <int D0> __device__ __forceinline__ void pv_reads(VFrag& f, int vb) {
    f.l0 = tr_read<v_rd_off(D0, 0, 0)>(vb); f.h0 = tr_read<v_rd_off(D0, 0, 1)>(vb); f.l1 = tr_read<v_rd_off(D0, 1, 0)>(vb); f.h1 = tr_read<v_rd_off(D0, 1, 1)>(vb);
    f.l2 = tr_read<v_rd_off(D0, 2, 0)>(vb); f.h2 = tr_read<v_rd_off(D0, 2, 1)>(vb); f.l3 = tr_read<v_rd_off(D0, 3, 0)>(vb); f.h3 = tr_read<v_rd_off(D0, 3, 1)>(vb);
}
__device__ __forceinline__ void pv_mma(f32x16& od, const VFrag& f, bf16x8 pa0, bf16x8 pa1, bf16x8 pa2, bf16x8 pa3) {
    od = __builtin_amdgcn_mfma_f32_32x32x16_bf16(pa0, PK(f.l0, f.h0), od, 0, 0, 0);
    od = __builtin_amdgcn_mfma_f32_32x32x16_bf16(pa1, PK(f.l1, f.h1), od, 0, 0, 0);
    od = __builtin_amdgcn_mfma_f32_32x32x16_bf16(pa2, PK(f.l2, f.h2), od, 0, 0, 0);
    od = __builtin_amdgcn_mfma_f32_32x32x16_bf16(pa3, PK(f.l3, f.h3), od, 0, 0, 0);
}
__device__ __forceinline__ void pv_all(f32x16 (&o)[4], int vb, bf16x8 pa0, bf16x8 pa1, bf16x8 pa2, bf16x8 pa3) {
    VFrag fa, fb;
    pv_reads<0>(fa, vb); pv_reads<1>(fb, vb);
    asm volatile("s_waitcnt lgkmcnt(8)" ::: "memory"); SBAR(); pv_mma(o[0], fa, pa0, pa1, pa2, pa3); SBAR();
    pv_reads<2>(fa, vb);
    asm volatile("s_waitcnt lgkmcnt(8)" ::: "memory"); SBAR(); pv_mma(o[1], fb, pa0, pa1, pa2, pa3); SBAR();
    pv_reads<3>(fb, vb);
    asm volatile("s_waitcnt lgkmcnt(8)" ::: "memory"); SBAR(); pv_mma(o[2], fa, pa0, pa1, pa2, pa3); SBAR();
    asm volatile("s_waitcnt lgkmcnt(0)" ::: "memory"); SBAR(); pv_mma(o[3], fb, pa0, pa1, pa2, pa3);
}
#undef PK
template <bool ISB>
__device__ __forceinline__ void attn_unit(LAS unsigned char* lds, const bf16_t* __restrict__ QKVG, bf16_t* __restrict__ OAB, const float* __restrict__ sink, const float* __restrict__ rpb,
                                          int b, int hh, int blk) {
    int tid = threadIdx.x; asm volatile("" : "+v"(tid));
    const int wid = __builtin_amdgcn_readfirstlane(tid >> 6), lane = tid & 63, r32 = lane & 31, hi = lane >> 5;
    LAS unsigned char* V_lds = lds + OFF_V; LAS unsigned char* K_lds = lds + OFF_K;
    LAS float* wsc = (LAS float*)(lds + OFF_WS) + wid * 64;
    LAS float* tbl = (LAS float*)(lds + OFF_TBL);
    int qrow0, qcol, kcol, vcol, ocol, nt, lat0;
    int qoff = (wid & 1) * 32 + r32;
    int rq = 0, wlo = 0;
    if (ISB) {
        const int r0 = blk * 4; rq = r0 + (wid >> 1); wlo = min(max(rq - 4, 0), 120);
        const int kr0 = min(max(r0 - 4, 0), 120), kr1 = min(max(r0 + 3 - 4, 0), 120) + 8;
        lat0 = kr0; nt = 4 + (kr1 - kr0);
        qrow0 = b * SEQ + rq * 64 + (wid & 1) * 32; qcol = C_QB + hh * 128; kcol = C_KB + hh * 128; vcol = C_VB + hh * 128; ocol = 1024 + hh * 128;
    } else {
        const int t0 = blk * 64; const int jl0 = t0 >= 128 ? 0 : (128 - t0) / 64; const int jl1 = min(5, (SEQ + 128 - t0) / 64);
        lat0 = jl0; nt = 4 + (jl1 - jl0);
        const int head = hh * 4 + (wid >> 1);
        qrow0 = b * SEQ + t0 + (wid & 1) * 32; qcol = C_QA + head * 128; kcol = C_KA + hh * 128; vcol = C_VA + hh * 128; ocol = head * 128;
    }
    auto tile_row = [&](int i) -> int {
        if (i < 4) return MTOK + b * CTXL + 64 * i;
        if (ISB) return b * SEQ + (lat0 + i - 4) * 64;
        return b * SEQ + blk * 64 - 128 + 64 * (lat0 + i - 4);
    };
    bf16x8 qr[8];
    { const bf16_t* Qw = QKVG + (size_t)(qrow0 + r32) * DIN + qcol + hi * 8;
#pragma unroll
      for (int d0 = 0; d0 < 8; ++d0) qr[d0] = *(const bf16x8*)(Qw + d0 * 16); }
    float m_reg, l_reg;
    if (ISB) { m_reg = NEGBIG; l_reg = 0.f; for (int i = tid; i < 465; i += 512) tbl[i] = rpb[hh * 465 + i] * LOG2E; }
    else { m_reg = sink[hh * 4 + (wid >> 1)] * LOG2E; l_reg = 1.f; }
    f32x16 o[4];
#pragma unroll
    for (int d = 0; d < 4; ++d)
#pragma unroll
        for (int r = 0; r < 16; ++r) o[d][r] = 0.f;
    const int vb0 = (int)(uintptr_t)V_lds + v_rd_base(lane);
    unsigned koff[2], voff[2];
#pragma unroll
    for (int i = 0; i < 2; ++i) { const int g = (i * 8 + wid) * 64 + lane;
        { const int row = g >> 4, c = (g & 15) ^ (row & 7); koff[i] = (unsigned)(row * DIN + c * 8) * 2u; }
        { const int sub = g >> 5, kk = (sub >> 2) * 8 + ((g >> 2) & 7), c = (sub & 3) * 32 + (g & 3) * 8, k = (kk & ~0xC) | ((kk & 4) << 1) | ((kk & 8) >> 1); voff[i] = (unsigned)(k * DIN + c) * 2u; } }
    const unsigned ldsw = (unsigned)wid * 1024u;
    const int kb0 = r32 * 256 + (((0 + hi) ^ (r32 & 7)) << 4), kb1 = r32 * 256 + (((2 + hi) ^ (r32 & 7)) << 4), kb2 = r32 * 256 + (((4 + hi) ^ (r32 & 7)) << 4), kb3 = r32 * 256 + (((6 + hi) ^ (r32 & 7)) << 4);
#define SSTAGE(R0, bb) do { const char* gk_ = (const char*)(QKVG + (size_t)(R0) * DIN + kcol); const char* gv_ = (const char*)(QKVG + (size_t)(R0) * DIN + vcol); \
        _Pragma("unroll") for (int _i = 0; _i < 2; ++_i) { \
            __builtin_amdgcn_global_load_lds((const unsigned*)(gk_ + koff[_i]), (LAS unsigned*)(K_lds + (bb) * SHM_K + ldsw + _i * 8192), 16, 0, 0); \
            __builtin_amdgcn_global_load_lds((const unsigned*)(gv_ + voff[_i]), (LAS unsigned*)(V_lds + (bb) * SHM_V + ldsw + _i * 8192), 16, 0, 0); } } while (0)
#define PK4(P, BASE, OUT) do { unsigned a0 = cvt_pk_bf16(P[BASE + 0], P[BASE + 1]), a1 = cvt_pk_bf16(P[BASE + 2], P[BASE + 3]);   \
    unsigned b0 = cvt_pk_bf16(P[BASE + 4], P[BASE + 5]), b1 = cvt_pk_bf16(P[BASE + 6], P[BASE + 7]);                              \
    auto r0 = __builtin_amdgcn_permlane32_swap(a0, b0, false, false); auto r1 = __builtin_amdgcn_permlane32_swap(a1, b1, false, false); \
    u32x4 w = {r0[0], r1[0], r0[1], r1[1]}; OUT = *reinterpret_cast<bf16x8*>(&w); } while (0)
#define ATT_FINISH(VS) do { \
        float pmax = p0[0]; \
        _Pragma("unroll") for (int r = 1; r < 16; ++r) pmax = fmaxf(pmax, p0[r]); \
        _Pragma("unroll") for (int r = 0; r < 16; ++r) pmax = fmaxf(pmax, p1[r]); \
        { auto rr = __builtin_amdgcn_permlane32_swap(__float_as_uint(pmax), __float_as_uint(pmax), false, false); \
          pmax = fmaxf(__uint_as_float(rr[0]), __uint_as_float(rr[1])); } \
        if (!__all(pmax - m_reg <= 8.0f)) { \
            const float mn = fmaxf(m_reg, pmax); const float alpha = __builtin_amdgcn_exp2f(m_reg - mn); m_reg = mn; l_reg *= alpha; \
            if (hi == 0) wsc[r32] = alpha; asm volatile("s_waitcnt lgkmcnt(0)" ::: "memory"); \
            _Pragma("unroll") for (int r = 0; r < 16; ++r) { const float al = wsc[crow(r, hi)]; \
                _Pragma("unroll") for (int d = 0; d < 4; ++d) o[d][r] *= al; } \
            asm volatile("s_waitcnt lgkmcnt(0)" ::: "memory"); } \
        float ps = 0.f; \
        _Pragma("unroll") for (int r = 0; r < 16; ++r) { p0[r] = __builtin_amdgcn_exp2f(p0[r] - m_reg); ps += p0[r]; } \
        _Pragma("unroll") for (int r = 0; r < 16; ++r) { p1[r] = __builtin_amdgcn_exp2f(p1[r] - m_reg); ps += p1[r]; } \
        { auto rr = __builtin_amdgcn_permlane32_swap(__float_as_uint(ps), __float_as_uint(ps), false, false); \
          ps = __uint_as_float(rr[0]) + __uint_as_float(rr[1]); } \
        l_reg += ps; \
        bf16x8 pa0, pa1, pa2, pa3; \
        PK4(p0, 0, pa0); PK4(p0, 8, pa1); PK4(p1, 0, pa2); PK4(p1, 8, pa3); \
        pv_all(o, vb0 + (VS) * SHM_V, pa0, pa1, pa2, pa3); } while (0)
    SSTAGE(tile_row(0), 0); asm volatile("s_waitcnt vmcnt(0) lgkmcnt(0)" ::: "memory"); __builtin_amdgcn_s_barrier(); asm volatile("" ::: "memory");
    const bool late = wid >= 4; bool pending = false; int bprev = 0;
    f32x16 p0, p1;
#pragma unroll
    for (int r = 0; r < 16; ++r) { p0[r] = 0.f; p1[r] = 0.f; }
    int bb = 0, bn = 1;
    for (int i = 0; i < nt; ++i) {
        if (i + 1 < nt) SSTAGE(tile_row(i + 1), bn);
        if (late && pending) { ATT_FINISH(bprev); pending = false; }
        bool active = true; int dr = 0, mmode = 0;
        if (ISB) { if (i >= 4) { const int kr = lat0 + i - 4; active = (kr >= wlo) && (kr < wlo + 8); dr = kr - rq + 7; } }
        else { if (i >= 4) { const int jl = lat0 + i - 4; mmode = jl == 0 ? 1 : (jl == 4 ? 2 : 0); } }
        if (active) {
#pragma unroll
            for (int r = 0; r < 16; ++r) { p0[r] = 0.f; p1[r] = 0.f; }
            const LAS unsigned char* Ks = K_lds + bb * SHM_K;
#define KADDR(d0) (Ks + (((d0) & 3) == 0 ? kb0 : ((d0) & 3) == 1 ? kb1 : ((d0) & 3) == 2 ? kb2 : kb3) + ((d0) >> 2) * 128)
#define LOADG(F, g) do { F[0] = *(const LAS bf16x8*)(KADDR(2 * (g))); F[1] = *(const LAS bf16x8*)(KADDR(2 * (g)) + 8192); F[2] = *(const LAS bf16x8*)(KADDR(2 * (g) + 1)); F[3] = *(const LAS bf16x8*)(KADDR(2 * (g) + 1) + 8192); } while (0)
#define MMAG(F, g) do { p0 = __builtin_amdgcn_mfma_f32_32x32x16_bf16(F[0], qr[2 * (g)], p0, 0, 0, 0); p1 = __builtin_amdgcn_mfma_f32_32x32x16_bf16(F[1], qr[2 * (g)], p1, 0, 0, 0); \
                p0 = __builtin_amdgcn_mfma_f32_32x32x16_bf16(F[2], qr[2 * (g) + 1], p0, 0, 0, 0); p1 = __builtin_amdgcn_mfma_f32_32x32x16_bf16(F[3], qr[2 * (g) + 1], p1, 0, 0, 0); } while (0)
            { bf16x8 fa[4], fb[4];
              LOADG(fa, 0); LOADG(fb, 1); SBAR();
              MMAG(fa, 0); SBAR(); LOADG(fa, 2); SBAR();
              MMAG(fb, 1); SBAR(); LOADG(fb, 3); SBAR();
              MMAG(fa, 2); SBAR();
              MMAG(fb, 3); SBAR(); }
#undef KADDR
#undef LOADG
#undef MMAG
            int hi4 = 4 * hi; asm volatile("" : "+v"(hi4));
            if (ISB) {
                if (i >= 4) { int qo_ = qoff; asm volatile("" : "+v"(qo_)); const int cs = min(max(qo_ - 8, 0), 48); const LAS float* tb = tbl + dr * 31 + 15 - qo_;
#pragma unroll
                    for (int r = 0; r < 16; ++r) { const int c0 = crow(r, 0) + hi4, c1 = 32 + c0;
                        const float b0 = tb[c0], b1 = tb[c1];
                        p0[r] = ((unsigned)(c0 - cs) < 16u) ? p0[r] + b0 : NEGBIG;
                        p1[r] = ((unsigned)(c1 - cs) < 16u) ? p1[r] + b1 : NEGBIG; } }
            } else {
                int qo_ = qoff; asm volatile("" : "+v"(qo_));
                if (mmode == 1) {
#pragma unroll
                    for (int r = 0; r < 16; ++r) { const int c0 = crow(r, 0) + hi4, c1 = 32 + c0; p0[r] = c0 >= qo_ ? p0[r] : NEGBIG; p1[r] = c1 >= qo_ ? p1[r] : NEGBIG; } }
                else if (mmode == 2) {
#pragma unroll
                    for (int r = 0; r < 16; ++r) { const int c0 = crow(r, 0) + hi4, c1 = 32 + c0; p0[r] = c0 <= qo_ ? p0[r] : NEGBIG; p1[r] = c1 <= qo_ ? p1[r] : NEGBIG; } }
            }
            if (!late) { ATT_FINISH(bb); } else { pending = true; bprev = bb; }
        }
        asm volatile("s_waitcnt vmcnt(0) lgkmcnt(0)" ::: "memory");
        __builtin_amdgcn_s_barrier(); asm volatile("" ::: "memory");
        bb = bb == 2 ? 0 : bb + 1; bn = bn == 2 ? 0 : bn + 1;
    }
    if (late && pending) { ATT_FINISH(bprev); }
#undef ATT_FINISH
#undef PK4
#undef SSTAGE
    if (hi == 0) wsc[r32] = l_reg; asm volatile("s_waitcnt lgkmcnt(0)" ::: "memory");
    bf16_t* Ow = OAB + (size_t)qrow0 * DM + ocol;
#pragma unroll
    for (int r = 0; r < 16; ++r) { const int orow = crow(r, hi); const float rl = __builtin_amdgcn_rcpf(wsc[orow]);
#pragma unroll
        for (int d0 = 0; d0 < 4; ++d0) { const unsigned w = cvt_pk_bf16(o[d0][r] * rl, 0.f); Ow[(size_t)orow * DM + d0 * 32 + r32] = (bf16_t)(w & 0xffffu); } }
    asm volatile("s_waitcnt lgkmcnt(0)" ::: "memory");
    __syncthreads();
}
}

template <int MODE> __device__ __forceinline__ int dest_row(int o) {
    if (MODE == 1) { if (o >= C_VA) return o; const int base = o & ~63, w = o & 63; return base + (w < 32 ? 8 * (w >> 2) + (w & 3) : 8 * ((w - 32) >> 2) + 4 + (w & 3)); }
    if (MODE == 2) { if (o < DFF) return 256 * (o >> 7) + (o & 127); const int q = o - DFF; return 256 * (q >> 7) + 128 + (q & 127); }
    return o;
}
template <int MODE> __device__ __forceinline__ void p0_transpose_item(const float* __restrict__ W, int K, int N, bf16_t* __restrict__ WT, LAS float* scr, int item, int lane) {
    const int nblk = N / 32, kb = item / nblk, nb = item % nblk, k0 = 64 * kb, n0 = 32 * nb;
    float tv[32];
#pragma unroll
    for (int i = 0; i < 32; ++i) { const int kk = 2 * i + (lane >> 5); tv[i] = __builtin_nontemporal_load(W + (size_t)(k0 + kk) * N + n0 + (lane & 31)); }
#pragma unroll
    for (int i = 0; i < 32; ++i) { const int kk = 2 * i + (lane >> 5); scr[kk * 33 + (lane & 31)] = tv[i]; }
    asm volatile("s_waitcnt lgkmcnt(0)" ::: "memory");
    const int c = lane & 7;
#pragma unroll
    for (int j = 0; j < 4; ++j) { const int n = (lane >> 3) + 8 * j; const LAS float* s = scr + (8 * c) * 33 + n;
        u32x4 o; o.x = cvt_pk_bf16(s[0 * 33], s[1 * 33]); o.y = cvt_pk_bf16(s[2 * 33], s[3 * 33]); o.z = cvt_pk_bf16(s[4 * 33], s[5 * 33]); o.w = cvt_pk_bf16(s[6 * 33], s[7 * 33]);
        *(u32x4*)(WT + (size_t)dest_row<MODE>(n0 + n) * K + k0 + 8 * c) = o; }
    asm volatile("s_waitcnt lgkmcnt(0)" ::: "memory");
}

struct Args { const float* in[20]; float* out; unsigned char* ws; int ph_lo, ph_hi; };
enum { I_X = 0, I_C, I_CTX, I_CCTX, I_WMOD, I_BMOD, I_GAPRE, I_GAPOST, I_GFPRE, I_GFPOST, I_WIN, I_SINK, I_RPB, I_WBA, I_WBB, I_WO, I_WUP, I_CONVW, I_CONVB, I_WDN };
constexpr int NPHASE = 11;

__global__ void __launch_bounds__(512, 2) fwd_mega(Args args) {
    extern __shared__ __attribute__((aligned(16))) unsigned char lds_raw[];
    LAS unsigned char* lds = (LAS unsigned char*)lds_raw;
    cg::grid_group grid = cg::this_grid();
    const int tid = threadIdx.x, lane = tid & 63, wave = __builtin_amdgcn_readfirstlane(tid >> 6);
    const int G = gridDim.x, bid = blockIdx.x;
    const int gw = bid * 8 + wave, NGW = G * 8;
    unsigned char* ws = args.ws;
    float* MOD = (float*)(ws + WS_MOD); float* ROPEC = (float*)(ws + WS_ROPEC); float* ROPES = (float*)(ws + WS_ROPES);
    bf16_t* WIN = (bf16_t*)(ws + WS_WIN); bf16_t* WBA = (bf16_t*)(ws + WS_WBA); bf16_t* WBB = (bf16_t*)(ws + WS_WBB); bf16_t* WO = (bf16_t*)(ws + WS_WO);
    bf16_t* WUP = (bf16_t*)(ws + WS_WUP); bf16_t* WDN = (bf16_t*)(ws + WS_WDN);
    bf16_t* H = (bf16_t*)(ws + WS_H); bf16_t* Z = H; bf16_t* F = H;
    bf16_t* OAB = (bf16_t*)(ws + WS_OAB); bf16_t* H2 = OAB;
    bf16_t* QKVG = (bf16_t*)(ws + WS_QKVG); bf16_t* Y = (bf16_t*)(ws + WS_Y); bf16_t* ACT = (bf16_t*)(ws + WS_ACT); bf16_t* HALO = (bf16_t*)(ws + WS_HALO);
    const int lo = args.ph_lo, hi_ph = args.ph_hi;
    volatile LAS unsigned* MISC = (volatile LAS unsigned*)(lds + 131072 + 320);
    if (tid < 32) MISC[tid] = 0u;
    __syncthreads();
    XcdBarrier xbar = xcd_barrier_post((unsigned*)(ws + WS_BAR), MISC + 8);
#ifndef REPMASK
#define REPMASK 0
#endif
#define NREP(k) ((((REPMASK) >> (k)) & 1) ? 2 : 1)
#define IN(k) (lo <= (k) && (k) < hi_ph)
#define SEAM(k) do { if (IN(k) && IN((k) + 1)) xcd_barrier(xbar); } while (0)
    if (args.ph_lo > NPHASE) grid.sync();

    for (int rep_ = 0; rep_ < NREP(0); ++rep_) if (IN(0)) {
        int tid = threadIdx.x; asm volatile("" : "+v"(tid)); const int lane = tid & 63; (void)lane;
        LAS float* sl = (LAS float*)lds;
        LAS float* red = sl + 5 * DM;
        const float* c = args.in[I_C]; const float* cctx = args.in[I_CCTX];
        for (int i = tid; i < 5 * DM; i += 512) { const int b = i / DM, k = i % DM; const float v = b < 4 ? c[b * DM + k] : cctx[k]; sl[i] = v / (1.0f + __expf(-v)); }
        __syncthreads();
        const float* wmod = args.in[I_WMOD]; const float* bmod = args.in[I_BMOD];
        for (int item = bid; item < NMOD / 32; item += G) {
            const int n0 = item * 32, cn = tid & 31, kg = tid >> 5;
            float a0 = 0.f, a1 = 0.f, a2 = 0.f, a3 = 0.f, a4 = 0.f;
            const float* wp = wmod + (size_t)(kg * 128) * NMOD + n0 + cn; const LAS float* sp = sl + kg * 128;
#pragma unroll 32
            for (int kk = 0; kk < 128; ++kk) { const float w = __builtin_nontemporal_load(wp + (size_t)kk * NMOD);
                a0 += sp[kk] * w; a1 += sp[DM + kk] * w; a2 += sp[2 * DM + kk] * w; a3 += sp[3 * DM + kk] * w; a4 += sp[4 * DM + kk] * w; }
            LAS float* rp = red + (kg * 32 + cn) * 5; rp[0] = a0; rp[1] = a1; rp[2] = a2; rp[3] = a3; rp[4] = a4;
            __syncthreads();
            if (tid < 160) { const int b = tid >> 5, cn2 = tid & 31; float s = 0.f;
#pragma unroll
                for (int q = 0; q < 16; ++q) s += red[(q * 32 + cn2) * 5 + b];
                MOD[b * NMOD + n0 + cn2] = s + bmod[n0 + cn2]; }
            __syncthreads();
        }
        for (int i = bid * 512 + tid; i < 128 * 32; i += G * 512) { const int pos = i >> 5, j = i & 31;
            const float inv = powf(10000.0f, -(float)j / 32.0f); const float ang = (float)pos * inv; ROPEC[i] = cosf(ang); ROPES[i] = sinf(ang); }
        __syncthreads();
        LAS float* scr = (LAS float*)(lds + wave * 16384);
        constexpr int I_IN = (DM / 64) * (DIN / 32), I_BR = (1024 / 64) * (DM / 32), I_O = (DM / 64) * (DM / 32), I_UP = (DM / 64) * (DUP / 32), I_DN = (DFF / 64) * (DM / 32);
        constexpr int NITEMS = I_IN + 2 * I_BR + I_O + I_UP + I_DN;
        for (int it = gw; it < NITEMS; it += NGW) {
            int r = it;
            if (r < I_IN) { p0_transpose_item<1>(args.in[I_WIN], DM, DIN, WIN, scr, r, lane); continue; } r -= I_IN;
            if (r < I_BR) { p0_transpose_item<0>(args.in[I_WBA], 1024, DM, WBA, scr, r, lane); continue; } r -= I_BR;
            if (r < I_BR) { p0_transpose_item<0>(args.in[I_WBB], 1024, DM, WBB, scr, r, lane); continue; } r -= I_BR;
            if (r < I_O) { p0_transpose_item<0>(args.in[I_WO], DM, DM, WO, scr, r, lane); continue; } r -= I_O;
            if (r < I_UP) { p0_transpose_item<2>(args.in[I_WUP], DM, DUP, WUP, scr, r, lane); continue; } r -= I_UP;
            p0_transpose_item<0>(args.in[I_WDN], DFF, DM, WDN, scr, r, lane);
        }
        __syncthreads();
    }
    SEAM(0);

    for (int rep_ = 0; rep_ < NREP(1); ++rep_) if (IN(1)) {
        int tid = threadIdx.x; asm volatile("" : "+v"(tid)); const int lane = tid & 63; (void)lane;
        const float* x = args.in[I_X]; const float* ctx = args.in[I_CTX]; const float* g = args.in[I_GAPRE];
#define P1_LOAD(V, R) do { const f32x4* xr_ = (const f32x4*)(srcb + (size_t)(R) * DM) + lane; \
        _Pragma("unroll") for (int j = 0; j < 8; ++j) V[j] = __builtin_nontemporal_load(xr_ + 64 * j); } while (0)
#define P1_PROC(V, R) do { float ss_ = 0.f; \
        _Pragma("unroll") for (int j = 0; j < 8; ++j) ss_ += (V[j].x * V[j].x + V[j].y * V[j].y) + (V[j].z * V[j].z + V[j].w * V[j].w); \
        const float rstd_ = 1.0f / sqrtf(wave_sum(ss_) * (1.0f / DM) + EPS); u32x2* hr_ = (u32x2*)(H + (row0 + (size_t)(R)) * DM) + lane; \
        _Pragma("unroll") for (int j = 0; j < 8; ++j) { const f32x4 hv = (V[j] * rstd_) * PA[j] + PB[j]; \
            u32x2 w; w.x = cvt_pk_bf16(hv.x, hv.y); w.y = cvt_pk_bf16(hv.z, hv.w); hr_[64 * j] = w; } } while (0)
        for (int b = 0; b < 5; ++b) {
            const int nrows = b < 4 ? SEQ : MCTX; const size_t row0 = b < 4 ? (size_t)b * SEQ : (size_t)MTOK;
            const float* srcb = b < 4 ? x + (size_t)b * SEQ * DM : ctx; const float* mb = MOD + b * NMOD;
            f32x4 PA[8], PB[8];
#pragma unroll
            for (int j = 0; j < 8; ++j) { const int col = 4 * (lane + 64 * j); PA[j] = *(const f32x4*)(g + col) * (*(const f32x4*)(mb + DM + col) + 1.0f); PB[j] = *(const f32x4*)(mb + col); }
            f32x4 va[8], vb[8]; int r = gw;
            if (r < nrows) P1_LOAD(va, r);
            for (; r < nrows; r += 2 * NGW) {
                const int r2 = r + NGW, r3 = r2 + NGW;
                if (r2 < nrows) P1_LOAD(vb, r2);
                P1_PROC(va, r);
                if (r3 < nrows) P1_LOAD(va, r3);
                if (r2 < nrows) P1_PROC(vb, r2);
            }
        }
#undef P1_LOAD
#undef P1_PROC
    }
    SEAM(1);

    for (int rep_ = 0; rep_ < NREP(2); ++rep_) if (IN(2)) {
        pg8::Gemm g{H, WIN, DM, DM, DM, H, WIN}; pg8::Order S; S.init(MTOK / 256, DIN / 256, G, bid, 40);
        pg8::EpiQKV E{QKVG, ROPEC, ROPES};
        pg8::gemm_phase<pg8::EpiQKV, pg8::Order, true, true>(lds, g, S, E);
    }
    SEAM(2);

    for (int rep_ = 0; rep_ < NREP(3); ++rep_) if (IN(3)) {
        const float* sink = args.in[I_SINK]; const float* rpb = args.in[I_RPB];
#ifndef ATT_REP
#define ATT_REP 1
#endif
        const int vcu = (G % 8 == 0) ? (bid & 7) * (G >> 3) + (bid >> 3) : bid;
        for (int i0 = 0; i0 * G + vcu < 2048 * ATT_REP; ++i0) { const int i = i0 & 7;
            const int idx = (i >> 1) * G + vcu;
            if (idx >= 1024) continue;
            if (i & 1) { const int b = idx >> 8, h = (idx >> 5) & 7, rb = idx & 31; att::attn_unit<true>(lds, QKVG, OAB, sink, rpb, b, h, rb); }
            else { const int b = idx >> 8, kvh = (idx >> 7) & 1, blk = idx & 127; att::attn_unit<false>(lds, QKVG, OAB, sink, rpb, b, kvh, blk); }
        }
    }
    SEAM(3);

    for (int rep_ = 0; rep_ < NREP(4); ++rep_) if (IN(4)) {
        pg8::Gemm g{OAB, WBA, DM, 1024, 1024, OAB + 1024, WBB}; pg8::Order S; S.init(MTOK / 256, DM / 256, G, bid, 0, 1);
        pg8::EpiBranch2 E{Z, QKVG + C_GA, QKVG + C_GB};
        pg8::gemm_phase<pg8::EpiBranch2, pg8::Order, true, true>(lds, g, S, E);
    }
    SEAM(4);

    for (int rep_ = 0; rep_ < NREP(5); ++rep_) if (IN(5)) {
        pg8::Gemm g{Z, WO, DM, DM, DM, Z, WO}; pg8::Order S; S.init(MTOK / 256, DM / 256, G, bid, 0);
        pg8::EpiBf16 E{Y, DM};
        pg8::gemm_phase<pg8::EpiBf16, pg8::Order, true, true>(lds, g, S, E);
    }
    SEAM(5);

    for (int rep_ = 0; rep_ < NREP(6); ++rep_) if (IN(6)) {
        int tid = threadIdx.x; asm volatile("" : "+v"(tid)); const int lane = tid & 63; (void)lane;
        const float* x = args.in[I_X]; const float* gpost = args.in[I_GAPOST]; const float* gpre = args.in[I_GFPRE];
#define P6_LOAD(VX, VY, M) do { const f32x4* xr_ = (const f32x4*)(x + (size_t)(M) * DM) + lane; const u32x2* yr_ = (const u32x2*)(Y + (size_t)(M) * DM) + lane; \
        _Pragma("unroll") for (int j = 0; j < 8; ++j) VY[j] = yr_[64 * j]; \
        _Pragma("unroll") for (int j = 0; j < 8; ++j) VX[j] = __builtin_nontemporal_load(xr_ + 64 * j); } while (0)
#define P6_PROC(VX, VY, M) do { float ss_ = 0.f; \
        _Pragma("unroll") for (int j = 0; j < 8; ++j) { const float y0 = bf_lo(VY[j].x), y1 = bf_hi(VY[j].x), y2 = bf_lo(VY[j].y), y3 = bf_hi(VY[j].y); ss_ += (y0 * y0 + y1 * y1) + (y2 * y2 + y3 * y3); } \
        const float rstd_ = 1.0f / sqrtf(wave_sum(ss_) * (1.0f / DM) + EPS); float s2_ = 0.f; \
        _Pragma("unroll") for (int j = 0; j < 8; ++j) { \
            const f32x4 yv = {bf_lo(VY[j].x), bf_hi(VY[j].x), bf_lo(VY[j].y), bf_hi(VY[j].y)}; \
            VX[j] = VX[j] + A1[j] * (yv * rstd_); \
            s2_ += (VX[j].x * VX[j].x + VX[j].y * VX[j].y) + (VX[j].z * VX[j].z + VX[j].w * VX[j].w); } \
        const float rstd2_ = 1.0f / sqrtf(wave_sum(s2_) * (1.0f / DM) + EPS); u32x2* hr_ = (u32x2*)(H2 + (size_t)(M) * DM) + lane; \
        _Pragma("unroll") for (int j = 0; j < 8; ++j) { const f32x4 hv = (VX[j] * rstd2_) * A2[j] + B2[j]; \
            u32x2 w; w.x = cvt_pk_bf16(hv.x, hv.y); w.y = cvt_pk_bf16(hv.z, hv.w); hr_[64 * j] = w; } } while (0)
        for (int b = 0; b < NBATCH; ++b) {
            const float* mb = MOD + b * NMOD; const int mend = (b + 1) * SEQ;
            f32x4 A1[8], A2[8], B2[8];
#pragma unroll
            for (int j = 0; j < 8; ++j) { const int col = 4 * (lane + 64 * j);
                A1[j] = *(const f32x4*)(mb + 2 * DM + col) * *(const f32x4*)(gpost + col);
                A2[j] = *(const f32x4*)(gpre + col) * (*(const f32x4*)(mb + 4 * DM + col) + 1.0f); B2[j] = *(const f32x4*)(mb + 3 * DM + col); }
            f32x4 xa[8]; u32x2 ya[8];
            for (int m = b * SEQ + gw; m < mend; m += NGW) { P6_LOAD(xa, ya, m); P6_PROC(xa, ya, m); }
        }
#undef P6_LOAD
#undef P6_PROC
    }
    SEAM(6);

    for (int rep_ = 0; rep_ < NREP(7); ++rep_) if (IN(7)) {
        pg8::Gemm g{H2, WUP, DM, DM, DM, H2, WUP}; pg8::Order S; S.init(MTOK / 256, DUP / 256, G, bid, 0);
        pg8::EpiUp E{ACT, HALO, args.in[I_CONVW], args.in[I_CONVB]};
        pg8::gemm_phase<pg8::EpiUp, pg8::Order, true, true>(lds, g, S, E);
    }
    SEAM(7);

    for (int rep_ = 0; rep_ < NREP(8); ++rep_) if (IN(8)) {
        int tid = threadIdx.x; asm volatile("" : "+v"(tid)); const int lane = tid & 63; (void)lane;
        const float* cw = args.in[I_CONVW]; const float* cb = args.in[I_CONVB];
        constexpr int NC8 = DFF / 8;
        const int total = 512 * 2 * NC8;
        for (int it = bid * 512 + tid; it < total; it += G * 512) {
            const int cg8 = it % NC8, rs = it / NC8, side = rs & 1, k = rs >> 1;
            const int c0 = cg8 * 8, dcol = 256 * (c0 >> 7) + (c0 & 127);
            const bf16_t* hk = HALO + (size_t)k * 4 * DUP;
            u32x4 ma, mg, za, zg, pa, pg; const u32x4 zero = {0u, 0u, 0u, 0u};
            if (side == 0) {
                if ((k & 127) == 0) { ma = zero; mg = zero; } else { const bf16_t* hm = hk - 4 * DUP + 3 * DUP; ma = *(const u32x4*)(hm + dcol); mg = *(const u32x4*)(hm + dcol + 128); }
                za = *(const u32x4*)(hk + dcol); zg = *(const u32x4*)(hk + dcol + 128);
                pa = *(const u32x4*)(hk + DUP + dcol); pg = *(const u32x4*)(hk + DUP + dcol + 128);
            } else {
                ma = *(const u32x4*)(hk + 2 * DUP + dcol); mg = *(const u32x4*)(hk + 2 * DUP + dcol + 128);
                za = *(const u32x4*)(hk + 3 * DUP + dcol); zg = *(const u32x4*)(hk + 3 * DUP + dcol + 128);
                if ((k & 127) == 127) { pa = zero; pg = zero; } else { const bf16_t* hn = hk + 4 * DUP; pa = *(const u32x4*)(hn + dcol); pg = *(const u32x4*)(hn + dcol + 128); }
            }
            float res[8];
#pragma unroll
            for (int e = 0; e < 8; ++e) {
                const unsigned wm_a = ma[e >> 1], wz_a = za[e >> 1], wp_a = pa[e >> 1], wm_g = mg[e >> 1], wz_g = zg[e >> 1], wp_g = pg[e >> 1];
                const float am = (e & 1) ? bf_hi(wm_a) : bf_lo(wm_a), az = (e & 1) ? bf_hi(wz_a) : bf_lo(wz_a), ap = (e & 1) ? bf_hi(wp_a) : bf_lo(wp_a);
                const float gm = (e & 1) ? bf_hi(wm_g) : bf_lo(wm_g), gz = (e & 1) ? bf_hi(wz_g) : bf_lo(wz_g), gp = (e & 1) ? bf_hi(wp_g) : bf_lo(wp_g);
                const int ca = c0 + e, cgc = DFF + c0 + e;
                const float va = cb[ca] + cw[ca] * am + cw[DUP + ca] * az + cw[2 * DUP + ca] * ap;
                const float vg = cb[cgc] + cw[cgc] * gm + cw[DUP + cgc] * gz + cw[2 * DUP + cgc] * gp;
                res[e] = va * vg * sigmoidf_(vg);
            }
            u32x4 w; w.x = cvt_pk_bf16(res[0], res[1]); w.y = cvt_pk_bf16(res[2], res[3]); w.z = cvt_pk_bf16(res[4], res[5]); w.w = cvt_pk_bf16(res[6], res[7]);
            const int row = k * 64 + (side ? 63 : 0);
            *(u32x4*)(ACT + (size_t)row * DFF + c0) = w;
        }
    }
    SEAM(8);

    for (int rep_ = 0; rep_ < NREP(9); ++rep_) if (IN(9)) {
        pg8::Gemm g{ACT, WDN, DFF, DFF, DFF, ACT, WDN}; pg8::Order S; S.init(MTOK / 256, DM / 256, G, bid, 0);
        pg8::EpiBf16 E{F, DM};
        pg8::gemm_phase<pg8::EpiBf16, pg8::Order, true, true>(lds, g, S, E);
    }
    SEAM(9);

    for (int rep_ = 0; rep_ < NREP(10); ++rep_) if (IN(10)) {
        int tid = threadIdx.x; asm volatile("" : "+v"(tid)); const int lane = tid & 63; (void)lane;
        const float* gpost = args.in[I_GFPOST]; const float* gpost1 = args.in[I_GAPOST]; const float* x = args.in[I_X];
#define PA_LOAD(VX, VY, VF, M) do { const f32x4* xr_ = (const f32x4*)(x + (size_t)(M) * DM) + lane; const u32x2* yr_ = (const u32x2*)(Y + (size_t)(M) * DM) + lane; const u32x2* fr_ = (const u32x2*)(F + (size_t)(M) * DM) + lane; \
        _Pragma("unroll") for (int j = 0; j < 8; ++j) VY[j] = yr_[64 * j]; \
        _Pragma("unroll") for (int j = 0; j < 8; ++j) VF[j] = fr_[64 * j]; \
        _Pragma("unroll") for (int j = 0; j < 8; ++j) VX[j] = __builtin_nontemporal_load(xr_ + 64 * j); } while (0)
#define PA_PROC(VX, VY, VF, M) do { float ss_ = 0.f, sy_ = 0.f; \
        _Pragma("unroll") for (int j = 0; j < 8; ++j) { const float y0 = bf_lo(VY[j].x), y1 = bf_hi(VY[j].x), y2 = bf_lo(VY[j].y), y3 = bf_hi(VY[j].y); sy_ += (y0 * y0 + y1 * y1) + (y2 * y2 + y3 * y3); } \
        _Pragma("unroll") for (int j = 0; j < 8; ++j) { const float y0 = bf_lo(VF[j].x), y1 = bf_hi(VF[j].x), y2 = bf_lo(VF[j].y), y3 = bf_hi(VF[j].y); ss_ += (y0 * y0 + y1 * y1) + (y2 * y2 + y3 * y3); } \
        const float rstdy_ = 1.0f / sqrtf(wave_sum(sy_) * (1.0f / DM) + EPS); \
        const float rstd_ = 1.0f / sqrtf(wave_sum(ss_) * (1.0f / DM) + EPS); \
        f32x4* orow_ = (f32x4*)(args.out + (size_t)(M) * DM) + lane; \
        _Pragma("unroll") for (int j = 0; j < 8; ++j) { \
            const f32x4 yv = {bf_lo(VY[j].x), bf_hi(VY[j].x), bf_lo(VY[j].y), bf_hi(VY[j].y)}; \
            const f32x4 fv = {bf_lo(VF[j].x), bf_hi(VF[j].x), bf_lo(VF[j].y), bf_hi(VF[j].y)}; \
            const f32x4 x1 = VX[j] + A1[j] * (yv * rstdy_); \
            __builtin_nontemporal_store(x1 + A3[j] * (fv * rstd_), orow_ + 64 * j); } } while (0)
        for (int b = 0; b < NBATCH; ++b) {
            const float* mb = MOD + b * NMOD; const int mend = (b + 1) * SEQ;
            f32x4 A1[8], A3[8];
#pragma unroll
            for (int j = 0; j < 8; ++j) { const int col = 4 * (lane + 64 * j);
                A1[j] = *(const f32x4*)(mb + 2 * DM + col) * *(const f32x4*)(gpost1 + col);
                A3[j] = *(const f32x4*)(mb + 5 * DM + col) * *(const f32x4*)(gpost + col); }
            f32x4 xa[8]; u32x2 ya[8], fa[8];
            for (int m = b * SEQ + gw; m < mend; m += NGW) { PA_LOAD(xa, ya, fa, m); PA_PROC(xa, ya, fa, m); }
        }
#undef PA_LOAD
#undef PA_PROC
    }
#undef IN
#undef SEAM
}

extern "C" void kernel_launch(void* const* d_in, const int* in_sizes, int n_in, void* d_out, int out_size, void* d_ws, size_t ws_size, hipStream_t stream) {
    static int grid = 0;
    if (grid == 0) {
        if (n_in != 20 || in_sizes[0] != MTOK * DM || out_size != MTOK * DM || ws_size < WS_END) {
            fprintf(stderr, "kernel_launch: unexpected shapes: n_in %d in0 %d out %d ws %zu (need >= %zu)\n", n_in, n_in > 0 ? in_sizes[0] : -1, out_size, ws_size, (size_t)WS_END); grid = -1; return; }
        int dev = 0, cus = 0, per_cu = 0;
        if (hipGetDevice(&dev) != hipSuccess || hipDeviceGetAttribute(&cus, hipDeviceAttributeMultiprocessorCount, dev) != hipSuccess) { fprintf(stderr, "kernel_launch: device query failed\n"); grid = -1; return; }
        if (hipFuncSetAttribute((const void*)fwd_mega, hipFuncAttributeMaxDynamicSharedMemorySize, LDS_BYTES) != hipSuccess) { fprintf(stderr, "kernel_launch: hipFuncSetAttribute failed\n"); grid = -1; return; }
        if (hipOccupancyMaxActiveBlocksPerMultiprocessor(&per_cu, (const void*)fwd_mega, 512, LDS_BYTES) != hipSuccess || per_cu < 1) { fprintf(stderr, "kernel_launch: occupancy query says %d\n", per_cu); per_cu = 1; }
        (void)hipGetLastError();
        grid = cus * 1;
        if (grid != 256) fprintf(stderr, "kernel_launch: note: %d CUs\n", cus);
    }
    if (grid < 0) return;
    if (hipMemsetAsync(d_ws, 0, CTL_ZERO_BYTES, stream) != hipSuccess) { fprintf(stderr, "kernel_launch: memset failed\n"); return; }
    Args a{};
    for (int i = 0; i < 20; ++i) a.in[i] = (const float*)d_in[i];
    a.out = (float*)d_out; a.ws = (unsigned char*)d_ws;
#if MK_N_LAUNCHES == 1
    a.ph_lo = 0; a.ph_hi = NPHASE;
    void* kargs[] = {&a};
    hipError_t e = hipLaunchCooperativeKernel((const void*)fwd_mega, dim3(grid), dim3(512), kargs, LDS_BYTES, stream);
    if (e != hipSuccess) fprintf(stderr, "kernel_launch: cooperative launch failed: %s (grid %d)\n", hipGetErrorString(e), grid);
#else
    for (int p = 0; p < NPHASE; ++p) { a.ph_lo = p; a.ph_hi = p + 1;
        hipLaunchKernelGGL(fwd_mega, dim3(grid), dim3(512), LDS_BYTES, stream, a);
        const hipError_t le = hipPeekAtLastError(); if (le != hipSuccess) { fprintf(stderr, "kernel_launch: launch %d failed: %s\n", p, hipGetErrorName(le)); break; } }
#endif
}
```

```cpp
#include <hip/hip_runtime.h>
#include <hip/hip_cooperative_groups.h>
#include <cstdio>
#include <cstdint>
namespace cg = cooperative_groups;

#ifndef MK_N_LAUNCHES
#define MK_N_LAUNCHES 1
#endif

#define LAS __attribute__((address_space(3)))
typedef unsigned short bf16_t;
typedef short bf16x8 __attribute__((ext_vector_type(8)));
typedef short s16x4 __attribute__((ext_vector_type(4)));
typedef float f32x4 __attribute__((ext_vector_type(4)));
typedef float f32x2 __attribute__((ext_vector_type(2)));
typedef float f32x16 __attribute__((ext_vector_type(16)));
typedef unsigned u32x4 __attribute__((ext_vector_type(4)));
typedef unsigned u32x2 __attribute__((ext_vector_type(2)));
typedef int i32x4 __attribute__((ext_vector_type(4)));

constexpr int DM = 2048, NBATCH = 4, SEQ = 8192, CTXL = 256;
constexpr int MTOK = NBATCH * SEQ;
constexpr int MCTX = NBATCH * CTXL;
constexpr int MALL = MTOK + MCTX;
constexpr int DIN = 8704, DFF = 5632, DUP = 2 * DFF;
constexpr int C_QA = 0, C_KA = 1024, C_VA = 1280, C_QB = 1536, C_KB = 2560, C_VB = 3584, C_GA = 4608, C_GB = 6656;
constexpr int NMOD = 6 * DM;
constexpr float EPS = 1e-6f;
constexpr float LOG2E = 1.4426950408889634f;
constexpr float QSCALE = 0.08838834764831845f * LOG2E;
constexpr float NEGBIG = -1e30f;

constexpr size_t MiB = 1u << 20;
constexpr size_t WS_BAR = 16384, CTL_ZERO_BYTES = 64 * 1024;
constexpr size_t WS_MOD = 64 * 1024;
constexpr size_t WS_ROPEC = 512 * 1024;
constexpr size_t WS_ROPES = 768 * 1024;
constexpr size_t WS_SA = 1 * MiB;
constexpr size_t WS_SB = 1 * MiB + 256 * 1024;
constexpr size_t WS_CM = 1 * MiB + 512 * 1024;
constexpr size_t WS_WIN = 4 * MiB;
constexpr size_t WS_WBA = 38 * MiB;
constexpr size_t WS_WBB = 42 * MiB;
constexpr size_t WS_WO = 46 * MiB;
constexpr size_t WS_WUP = 54 * MiB;
constexpr size_t WS_WDN = 98 * MiB;
constexpr size_t WS_H = 120 * MiB;
constexpr size_t WS_OAB = 252 * MiB;
constexpr size_t WS_QKVG = 380 * MiB;
constexpr size_t WS_Y = 380 * MiB;
constexpr size_t WS_ACT = 508 * MiB;
constexpr size_t WS_HALO = 860 * MiB;
constexpr size_t WS_END = 941 * MiB;

constexpr int LDS_BYTES = 147456;

__device__ __forceinline__ unsigned cvt_pk_bf16(float lo, float hi) { unsigned r; asm volatile("v_cvt_pk_bf16_f32 %0, %1, %2" : "=v"(r) : "v"(lo), "v"(hi)); return r; }
__device__ __forceinline__ float bf_lo(unsigned w) { return __uint_as_float(w << 16); }
__device__ __forceinline__ float bf_hi(unsigned w) { return __uint_as_float(w & 0xffff0000u); }
__device__ __forceinline__ float wave_sum(float v) {
#pragma unroll
    for (int o = 1; o < 64; o <<= 1) v += __shfl_xor(v, o);
    return v;
}
__device__ __forceinline__ float wave_max(float v) {
#pragma unroll
    for (int o = 1; o < 64; o <<= 1) v = fmaxf(v, __shfl_xor(v, o));
    return v;
}
__device__ __forceinline__ unsigned pack_i8x4(float a, float b, float c, float d) {
    const int ia = __float2int_rn(a), ib = __float2int_rn(b), ic = __float2int_rn(c), id = __float2int_rn(d);
    return (unsigned)(ia & 0xff) | ((unsigned)(ib & 0xff) << 8) | ((unsigned)(ic & 0xff) << 16) | ((unsigned)(id & 0xff) << 24);
}
__device__ __forceinline__ float sigmoidf_(float x) { return __builtin_amdgcn_rcpf(1.0f + __builtin_amdgcn_exp2f(-x * LOG2E)); }
template <int CTRL> __device__ __forceinline__ float dppf(float old, float src) {
    return __int_as_float(__builtin_amdgcn_update_dpp(__float_as_int(old), __float_as_int(src), CTRL, 0xf, 0xf, false));
}


#define XB_TMO      128
#define XB_XCNT(j)  (256  + 64 * (j))
#define XB_XSUB(j)  (1280 + 64 * (j))
#define XB_XGEN(j)  (2304 + 64 * (j))
#define XB_TOP      3328
#define XB_TOPGEN   3392
#define XCD_BAR_WORDS 3456
#define XB_SPIN_CAP (1u << 18)
__device__ __forceinline__ unsigned xb_ld(unsigned* p)              { return __hip_atomic_load(p, __ATOMIC_RELAXED, __HIP_MEMORY_SCOPE_AGENT); }
__device__ __forceinline__ unsigned xb_add(unsigned* p, unsigned v) { return __hip_atomic_fetch_add(p, v, __ATOMIC_RELAXED, __HIP_MEMORY_SCOPE_AGENT); }
__device__ __forceinline__ unsigned xb_xcc_id() { return (unsigned)__builtin_amdgcn_s_getreg((3 << 11) | 20) & 0xFu; }
#define XB_SPIN(cond, bar) do { unsigned _sp = 0; while (cond) { __builtin_amdgcn_s_sleep(1); \
    if ((++_sp & 255u) == 0u) { if (xb_ld(&(bar)[XB_TMO])) break; if (_sp > XB_SPIN_CAP) { atomicAdd(&(bar)[XB_TMO], 1u); break; } } } } while (0)
struct XcdBarrier { unsigned* bar; unsigned x; volatile LAS unsigned* st; };
__device__ __forceinline__ XcdBarrier xcd_barrier_post(unsigned* bar, volatile LAS unsigned* st) {
    XcdBarrier b; b.bar = bar; b.x = xb_xcc_id(); b.st = st;
    if (threadIdx.x == 0) (void)xb_add(&bar[XB_XCNT(b.x)], 1u);
    return b;
}
__device__ __forceinline__ void xcd_barrier_complete(unsigned* bar, unsigned x, unsigned& nloc, unsigned& nx) {
    const unsigned G = gridDim.x * gridDim.y * gridDim.z;
    unsigned sum, cnt, mine, sp = 0u;
    for (;;) {
        sum = 0u; cnt = 0u; mine = 0u;
#pragma unroll
        for (unsigned j = 0; j < 16; ++j) { const unsigned c = xb_ld(&bar[XB_XCNT(j)]); sum += c; cnt += (c > 0u) ? 1u : 0u; mine = (j == x) ? c : mine; }
        if (sum == G) break;
        __builtin_amdgcn_s_sleep(1);
        if ((++sp & 255u) == 0u) { if (xb_ld(&bar[XB_TMO])) break; if (sp > XB_SPIN_CAP) { atomicAdd(&bar[XB_TMO], 1u); break; } }
    }
    nloc = mine > 0u ? mine : 1u; nx = cnt > 0u ? cnt : 1u;
}
__device__ __forceinline__ void xcd_barrier(const XcdBarrier& b) {
    asm volatile("s_waitcnt vmcnt(0)" ::: "memory");
    __syncthreads();
    if (threadIdx.x == 0) {
        unsigned* bar = b.bar;
        __builtin_amdgcn_s_waitcnt(0);
        unsigned nloc = b.st[0], nx = b.st[1];
        if (nloc == 0u) { xcd_barrier_complete(bar, b.x, nloc, nx); b.st[0] = nloc; b.st[1] = nx; }
        const unsigned old = xb_add(&bar[XB_XSUB(b.x)], 1u);
        const unsigned gen = old / nloc;
        if (old + 1u == (gen + 1u) * nloc) {
            __builtin_amdgcn_fence(__ATOMIC_RELEASE, "agent");
            asm volatile("s_waitcnt vmcnt(0)" ::: "memory");
            const unsigned og = xb_add(&bar[XB_TOP], 1u);
            const unsigned tg = og / nx;
            if (og + 1u == (tg + 1u) * nx) xb_add(&bar[XB_TOPGEN], 1u);
            else XB_SPIN(xb_ld(&bar[XB_TOPGEN]) == tg, bar);
            __builtin_amdgcn_fence(__ATOMIC_ACQUIRE, "agent");
            xb_add(&bar[XB_XGEN(b.x)], 1u);
            asm volatile("s_waitcnt vmcnt(0)" ::: "memory");
        } else {
            XB_SPIN(xb_ld(&bar[XB_XGEN(b.x)]) == gen, bar);
            __builtin_amdgcn_fence(__ATOMIC_ACQUIRE, "agent");
            asm volatile("s_waitcnt vmcnt(0)" ::: "memory");
        }
    }
    __syncthreads();
}

namespace pg8 {
constexpr int BM = 256, BK = 64, HALF = 128, HTB = HALF * BK * 2, STAGE_BYTES = 8 * HTB, NXCD = 8, WGM = 8;
__host__ __device__ __forceinline__ int lds_byte(int r, int c) { const int st = (r >> 4) * 2 + (c >> 5), rr = r & 15, cc = c & 31, ob = rr * 64 + cc * 2; return st * 1024 + (ob ^ (((ob >> 9) & 1) << 5)); }
__host__ __device__ __forceinline__ void stage_rc(int b, int& R, int& C) { const int st = b / 1024, sb = b % 1024, swz = sb ^ (((sb >> 9) & 1) << 5); R = (st >> 1) * 16 + swz / 64; C = (st & 1) * 32 + (swz % 64) / 2; }
__host__ __device__ __forceinline__ int perm32(int rho) { const int n = rho >> 4, i = rho & 15; return 8 * (i >> 2) + 4 * n + (i & 3); }

struct Unit { int pm, pn, seg; };
struct Gemm { const bf16_t* A; const bf16_t* Bt; int lda, ldb, K; const bf16_t* A2; const bf16_t* Bt2; };

struct Order {
    int nM, nN, nwg, G, c, extra, twoseg;
    __device__ void init(int nM_, int nN_, int G_, int c_, int extra_, int twoseg_ = 0) { nM = nM_; nN = nN_; nwg = nM * nN; G = G_; c = c_; extra = extra_; twoseg = twoseg_; }
    __device__ bool next(int i, Unit& u) const {
        u.seg = twoseg ? (i & 1) : 0; if (twoseg) i >>= 1;
        const long L = (long)i * G + c; if (L >= nwg + extra) return false;
        if (L >= nwg) { const int idx = (int)L - nwg, k = idx % 10; u.pm = 128 + idx / 10; u.pn = k < 2 ? 4 + k : 8 + k; return true; }
        int wgid = (int)L; { const int q = nwg / NXCD, r = nwg % NXCD, xcd = wgid % NXCD, off = wgid / NXCD; wgid = (xcd < r ? xcd * (q + 1) : r * (q + 1) + (xcd - r) * q) + off; }
        const int nig = WGM * nN, gid = wgid / nig, fm = gid * WGM, gsz = (nM - fm) < WGM ? (nM - fm) : WGM;
        u.pm = fm + ((wgid % nig) % gsz); u.pn = (wgid % nig) / gsz; return true;
    }
};

typedef f32x4 Acc[2][2][4][2];

struct EpiBf16 {
    static constexpr bool PERM = true, I8 = false; typedef f32x4 AccT;
    __device__ __forceinline__ static bool keep_acc(const Unit&) { return false; }
    bf16_t* O; int ldc;
    __device__ __forceinline__ void operator()(Acc& acc, const Unit& u, int wr, int wc, int fr, int fq) const {
        const int row0 = u.pm * BM + wr * 64 + fr, col0 = u.pn * BM + wc * 32 + 8 * fq;
#pragma unroll
        for (int ai = 0; ai < 2; ++ai)
#pragma unroll
            for (int m = 0; m < 4; ++m) { bf16_t* rowp = O + (size_t)(row0 + ai * HALF + m * 16) * ldc + col0;
#pragma unroll
                for (int bj = 0; bj < 2; ++bj) { const f32x4 v0 = acc[ai][bj][m][0], v1 = acc[ai][bj][m][1];
                    u32x4 w; w.x = cvt_pk_bf16(v0[0], v0[1]); w.y = cvt_pk_bf16(v0[2], v0[3]); w.z = cvt_pk_bf16(v1[0], v1[1]); w.w = cvt_pk_bf16(v1[2], v1[3]);
                    *(u32x4*)(rowp + bj * HALF) = w; } }
    }
};

struct EpiQKV {
    static constexpr bool PERM = true, I8 = false; typedef f32x4 AccT;
    __device__ __forceinline__ static bool keep_acc(const Unit&) { return false; }
    bf16_t* O; const float* rc; const float* rs;
    __device__ __forceinline__ void operator()(Acc& acc, const Unit& u, int wr, int wc, int fr, int fq) const {
        const int pn = u.pn; int mode = 0;
        if (pn <= 4) mode = (u.pm < 128) ? 1 : 0; else if (pn >= 6 && pn <= 9) mode = 2; else if (pn >= 18) mode = 3;
        const float qs = (pn < 4 || mode == 2) ? QSCALE : 1.0f;
        const int row0 = u.pm * BM + wr * 64 + fr, col0 = pn * BM + wc * 32 + 8 * fq;
        const int ridx = 16 * (wc & 1) + 4 * fq;
        f32x4 cq[2][4], sq[2][4];
#pragma unroll
        for (int ai = 0; ai < 2; ++ai)
#pragma unroll
            for (int m = 0; m < 4; ++m) { cq[ai][m] = (f32x4){1.f, 1.f, 1.f, 1.f}; sq[ai][m] = (f32x4){0.f, 0.f, 0.f, 0.f};
                if (mode == 1) { const int t = (row0 + ai * HALF + m * 16) & (SEQ - 1); const int pos = (wc >> 1) ? (t & 63) : (t >> 6); cq[ai][m] = *(const f32x4*)(rc + pos * 32 + ridx); sq[ai][m] = *(const f32x4*)(rs + pos * 32 + ridx); } }
#pragma unroll
        for (int ai = 0; ai < 2; ++ai)
#pragma unroll
            for (int m = 0; m < 4; ++m) { const int row = row0 + ai * HALF + m * 16; bf16_t* rowp = O + (size_t)row * DIN + col0;
                const f32x4 c4 = cq[ai][m], s4 = sq[ai][m];
#pragma unroll
                for (int bj = 0; bj < 2; ++bj) { f32x4 v0 = acc[ai][bj][m][0], v1 = acc[ai][bj][m][1];
                    if (mode == 1) { const f32x4 o0 = v0 * c4 - v1 * s4, o1 = v1 * c4 + v0 * s4; v0 = o0 * qs; v1 = o1 * qs; }
                    else if (mode == 2) { v0 = v0 * qs; v1 = v1 * qs; }
                    else if (mode == 3) {
#pragma unroll
                        for (int e = 0; e < 4; ++e) { v0[e] = sigmoidf_(v0[e]); v1[e] = sigmoidf_(v1[e]); } }
                    u32x4 w; w.x = cvt_pk_bf16(v0[0], v0[1]); w.y = cvt_pk_bf16(v0[2], v0[3]); w.z = cvt_pk_bf16(v1[0], v1[1]); w.w = cvt_pk_bf16(v1[2], v1[3]);
                    *(u32x4*)(rowp + bj * HALF) = w; } }
    }
};

struct EpiBranch2 {
    static constexpr bool PERM = true, I8 = false; typedef f32x4 AccT;
    __device__ __forceinline__ static bool keep_acc(const Unit& u) { return u.seg == 0; }
    bf16_t* Z; const bf16_t* GA; const bf16_t* GB;
    __device__ __forceinline__ void operator()(Acc& acc, const Unit& u, int wr, int wc, int fr, int fq) const {
        const int row0 = u.pm * BM + wr * 64 + fr, col0 = u.pn * BM + wc * 32 + 8 * fq;
        if (u.seg == 0) {
#pragma unroll
            for (int ai = 0; ai < 2; ++ai)
#pragma unroll
                for (int m = 0; m < 4; ++m) { const size_t ro = (size_t)(row0 + ai * HALF + m * 16) * DIN + col0;
#pragma unroll
                    for (int bj = 0; bj < 2; ++bj) { const u32x4 ga = *(const u32x4*)(GA + ro + bj * HALF), gb = *(const u32x4*)(GB + ro + bj * HALF);
                        f32x4 r0, r1;
                        r0[0] = bf_lo(ga.x) * __builtin_amdgcn_rcpf(fmaxf(bf_lo(gb.x), 1e-20f)); r0[1] = bf_hi(ga.x) * __builtin_amdgcn_rcpf(fmaxf(bf_hi(gb.x), 1e-20f));
                        r0[2] = bf_lo(ga.y) * __builtin_amdgcn_rcpf(fmaxf(bf_lo(gb.y), 1e-20f)); r0[3] = bf_hi(ga.y) * __builtin_amdgcn_rcpf(fmaxf(bf_hi(gb.y), 1e-20f));
                        r1[0] = bf_lo(ga.z) * __builtin_amdgcn_rcpf(fmaxf(bf_lo(gb.z), 1e-20f)); r1[1] = bf_hi(ga.z) * __builtin_amdgcn_rcpf(fmaxf(bf_hi(gb.z), 1e-20f));
                        r1[2] = bf_lo(ga.w) * __builtin_amdgcn_rcpf(fmaxf(bf_lo(gb.w), 1e-20f)); r1[3] = bf_hi(ga.w) * __builtin_amdgcn_rcpf(fmaxf(bf_hi(gb.w), 1e-20f));
                        acc[ai][bj][m][0] *= r0; acc[ai][bj][m][1] *= r1; } }
        } else {
            u32x4 gq[2][4][2];
#pragma unroll
            for (int ai = 0; ai < 2; ++ai)
#pragma unroll
                for (int m = 0; m < 4; ++m)
#pragma unroll
                    for (int bj = 0; bj < 2; ++bj) gq[ai][m][bj] = *(const u32x4*)(GB + (size_t)(row0 + ai * HALF + m * 16) * DIN + col0 + bj * HALF);
#pragma unroll
            for (int ai = 0; ai < 2; ++ai)
#pragma unroll
                for (int m = 0; m < 4; ++m) { const int row = row0 + ai * HALF + m * 16; bf16_t* zp = Z + (size_t)row * DM + col0;
#pragma unroll
                    for (int bj = 0; bj < 2; ++bj) { f32x4 v0 = acc[ai][bj][m][0], v1 = acc[ai][bj][m][1];
                        const u32x4 g = gq[ai][m][bj];
                        v0[0] *= fmaxf(bf_lo(g.x), 1e-20f); v0[1] *= fmaxf(bf_hi(g.x), 1e-20f); v0[2] *= fmaxf(bf_lo(g.y), 1e-20f); v0[3] *= fmaxf(bf_hi(g.y), 1e-20f);
                        v1[0] *= fmaxf(bf_lo(g.z), 1e-20f); v1[1] *= fmaxf(bf_hi(g.z), 1e-20f); v1[2] *= fmaxf(bf_lo(g.w), 1e-20f); v1[3] *= fmaxf(bf_hi(g.w), 1e-20f);
                        u32x4 w; w.x = cvt_pk_bf16(v0[0], v0[1]); w.y = cvt_pk_bf16(v0[2], v0[3]); w.z = cvt_pk_bf16(v1[0], v1[1]); w.w = cvt_pk_bf16(v1[2], v1[3]);
                        *(u32x4*)(zp + bj * HALF) = w; } }
        }
    }
};

struct EpiUp {
    static constexpr bool PERM = true, I8 = true; typedef f32x4 AccT;
    __device__ __forceinline__ static bool keep_acc(const Unit&) { return false; }
    bf16_t* ACT; bf16_t* HALO; const float* cw; const float* cb; const float* SA; const float* SB;
    __device__ __forceinline__ void operator()(Acc& acc, const Unit& u, int wr, int wc, int fr, int fq) const {
        int cc = wc * 32 + 8 * fq; asm volatile("" : "+v"(cc));
        const int acol = u.pn * HALF + cc;
        {
          f32x4 sb[2][2];
#pragma unroll
          for (int bj = 0; bj < 2; ++bj)
#pragma unroll
              for (int n = 0; n < 2; ++n) sb[bj][n] = *(const f32x4*)(SB + u.pn * BM + bj * HALF + cc + 4 * n);
#pragma unroll
          for (int ai = 0; ai < 2; ++ai)
#pragma unroll
              for (int m = 0; m < 4; ++m) { const float sa = SA[u.pm * BM + ai * HALF + wr * 64 + m * 16 + fr];
#pragma unroll
                  for (int bj = 0; bj < 2; ++bj)
#pragma unroll
                      for (int n = 0; n < 2; ++n) { const f32x4 q = acc[ai][bj][m][n]; f32x4 v;
#pragma unroll
                          for (int e = 0; e < 4; ++e) v[e] = (float)__float_as_int(q[e]) * (sa * sb[bj][n][e]);
                          acc[ai][bj][m][n] = v; } } }
        f32x4 cwa[4], cwg[4];
        { const int ca = acol, cg_ = DFF + acol;
            cwa[0] = *(const f32x4*)(cw + ca); cwa[1] = *(const f32x4*)(cw + DUP + ca); cwa[2] = *(const f32x4*)(cw + 2 * DUP + ca); cwa[3] = *(const f32x4*)(cb + ca);
            cwg[0] = *(const f32x4*)(cw + cg_); cwg[1] = *(const f32x4*)(cw + DUP + cg_); cwg[2] = *(const f32x4*)(cw + 2 * DUP + cg_); cwg[3] = *(const f32x4*)(cb + cg_); }
#pragma unroll
        for (int ai = 0; ai < 2; ++ai) { const int chunk = u.pm * 4 + ai * 2 + wr;
            if (fr < 2 || fr >= 14) { const int slot = fr < 2 ? fr : fr - 12;
                bf16_t* hp = HALO + ((size_t)(chunk * 4 + slot) * DUP + u.pn * BM + cc);
#pragma unroll
                for (int bj = 0; bj < 2; ++bj) { const f32x4 v0 = fr < 2 ? acc[ai][bj][0][0] : acc[ai][bj][3][0], v1 = fr < 2 ? acc[ai][bj][0][1] : acc[ai][bj][3][1];
                    u32x4 w; w.x = cvt_pk_bf16(v0[0], v0[1]); w.y = cvt_pk_bf16(v0[2], v0[3]); w.z = cvt_pk_bf16(v1[0], v1[1]); w.w = cvt_pk_bf16(v1[2], v1[3]);
                    *(u32x4*)(hp + bj * HALF) = w; } } }
#pragma unroll
        for (int n = 0; n < 2; ++n) {
            if (n == 1) { const int ca = acol + 4, cg_ = DFF + acol + 4;
                cwa[0] = *(const f32x4*)(cw + ca); cwa[1] = *(const f32x4*)(cw + DUP + ca); cwa[2] = *(const f32x4*)(cw + 2 * DUP + ca); cwa[3] = *(const f32x4*)(cb + ca);
                cwg[0] = *(const f32x4*)(cw + cg_); cwg[1] = *(const f32x4*)(cw + DUP + cg_); cwg[2] = *(const f32x4*)(cw + 2 * DUP + cg_); cwg[3] = *(const f32x4*)(cb + cg_); }
            const f32x4 wa0 = cwa[0], wa1 = cwa[1], wa2 = cwa[2], ba = cwa[3];
            const f32x4 wg0 = cwg[0], wg1 = cwg[1], wg2 = cwg[2], bg = cwg[3];
#pragma unroll
            for (int k = 0; k < 4; ++k)
#pragma unroll
                for (int ai = 0; ai < 2; ++ai) {
                    float va[4];
                    { float ra[4];
#pragma unroll
                      for (int m = 0; m < 4; ++m) ra[m] = acc[ai][0][m][n][k];
#pragma unroll
                      for (int m = 0; m < 4; ++m) {
                          const float oa = m > 0 ? dppf<0x121>(ra[m - 1], ra[m - 1]) : 0.f; const float pa = dppf<0x111>(oa, ra[m]);
                          const float qa = m < 3 ? dppf<0x12F>(ra[m + 1], ra[m + 1]) : 0.f; const float na = dppf<0x101>(qa, ra[m]);
                          va[m] = ba[k] + wa0[k] * pa + wa1[k] * ra[m] + wa2[k] * na; } }
                    { float rg[4];
#pragma unroll
                      for (int m = 0; m < 4; ++m) rg[m] = acc[ai][1][m][n][k];
#pragma unroll
                      for (int m = 0; m < 4; ++m) {
                          const float og = m > 0 ? dppf<0x121>(rg[m - 1], rg[m - 1]) : 0.f; const float pg = dppf<0x111>(og, rg[m]);
                          const float qg = m < 3 ? dppf<0x12F>(rg[m + 1], rg[m + 1]) : 0.f; const float ng = dppf<0x101>(qg, rg[m]);
                          const float vg = bg[k] + wg0[k] * pg + wg1[k] * rg[m] + wg2[k] * ng;
                          acc[ai][0][m][n][k] = va[m] * vg * sigmoidf_(vg); } }
                }
        }
        const int row0 = u.pm * BM + wr * 64 + fr;
#pragma unroll
        for (int ai = 0; ai < 2; ++ai)
#pragma unroll
            for (int m = 0; m < 4; ++m) { const f32x4 v0 = acc[ai][0][m][0], v1 = acc[ai][0][m][1];
                u32x4 w; w.x = cvt_pk_bf16(v0[0], v0[1]); w.y = cvt_pk_bf16(v0[2], v0[3]); w.z = cvt_pk_bf16(v1[0], v1[1]); w.w = cvt_pk_bf16(v1[2], v1[3]);
                *(u32x4*)(ACT + (size_t)(row0 + ai * HALF + m * 16) * DFF + acol) = w; }
    }
};

__device__ __forceinline__ f32x4 mma_one(bf16x8 a, bf16x8 b, f32x4 c) { return __builtin_amdgcn_mfma_f32_16x16x32_bf16(a, b, c, 0, 0, 0); }
__device__ __forceinline__ i32x4 mma_one(bf16x8 a, bf16x8 b, i32x4 c) { return __builtin_amdgcn_mfma_i32_16x16x64_i8(__builtin_bit_cast(i32x4, a), __builtin_bit_cast(i32x4, b), c, 0, 0, 0); }

template <bool I8> __device__ __forceinline__ f32x4 mma_sel(bf16x8 a, bf16x8 b, f32x4 c) {
    if constexpr (I8) return __builtin_bit_cast(f32x4, __builtin_amdgcn_mfma_i32_16x16x64_i8(__builtin_bit_cast(i32x4, a), __builtin_bit_cast(i32x4, b), __builtin_bit_cast(i32x4, c), 0, 0, 0));
    else return __builtin_amdgcn_mfma_f32_16x16x32_bf16(a, b, c, 0, 0, 0);
}
template <class Epi, class Sched, bool ALIGN_EPI, bool SP2>
__device__ __forceinline__ void gemm_phase(LAS unsigned char* lds, const Gemm g, const Sched& S, const Epi& E) {
    int tid = threadIdx.x; asm volatile("" : "+v"(tid));
    const int wid = __builtin_amdgcn_readfirstlane(tid >> 6), lane = tid & 63, wr = wid >> 2, wc = wid & 3, fr = lane & 15, fq = lane >> 4;
    const int K = g.K, nt = K / BK;
    unsigned voffA[2], voffB[2];
#pragma unroll
    for (int i = 0; i < 2; ++i) { int R, C; stage_rc(tid * 16 + i * 8192, R, C); const int Rb = Epi::PERM ? ((R & ~31) + perm32(R & 31)) : R;
        voffA[i] = (unsigned)(R * g.lda + C) * 2u; voffB[i] = (unsigned)(Rb * g.ldb + C) * 2u; }
    const size_t kstep = (size_t)(BK * 2);
    const size_t hA = (size_t)HALF * g.lda * 2, hB = (size_t)HALF * g.ldb * 2;
    const size_t tA = 2 * hA, tB = 2 * hB;
    const unsigned ldsw = (unsigned)wid * 1024u;
    const int aoff = lds_byte(wr * 64 + fr, fq * 8), boff = lds_byte(wc * 32 + fr, fq * 8);
#define PG8_SA(b, h) (((b) * 2 + (h)) * HTB)
#define PG8_SB(b, h) ((4 + (b) * 2 + (h)) * HTB)
#define PG8_STAGE(bufoff, gbase, voff) do { _Pragma("unroll") for (int _i = 0; _i < 2; ++_i) \
        __builtin_amdgcn_global_load_lds((const unsigned*)((const char*)(gbase) + (voff)[_i]), (LAS unsigned*)(lds + (bufoff) + ldsw + _i * 8192), 16, 0, 0); } while (0)
#define PG8_LDA(dst, b, h) do { _Pragma("unroll") for (int m = 0; m < 4; ++m) _Pragma("unroll") for (int k = 0; k < 2; ++k) dst[m][k] = *(const LAS bf16x8*)(lds + PG8_SA(b, h) + aoff + m * 2048 + k * 1024); } while (0)
#define PG8_LDB(dst, b, h) do { _Pragma("unroll") for (int n = 0; n < 2; ++n) _Pragma("unroll") for (int k = 0; k < 2; ++k) dst[n][k] = *(const LAS bf16x8*)(lds + PG8_SB(b, h) + boff + n * 2048 + k * 1024); } while (0)
#define PG8_MMA(ai, bj, At, Bt) do { __builtin_amdgcn_s_setprio(1); _Pragma("unroll") for (int m = 0; m < 4; ++m) _Pragma("unroll") for (int n = 0; n < 2; ++n) _Pragma("unroll") for (int k = 0; k < 2; ++k) \
        acc[ai][bj][m][n] = mma_sel<Epi::I8>(Bt[n][k], At[m][k], acc[ai][bj][m][n]); __builtin_amdgcn_s_setprio(0); } while (0)
#define PG8_WAIT_V(n) asm volatile("s_waitcnt vmcnt(" #n ")" ::: "memory")
#define PG8_WAIT_L(n) asm volatile("s_waitcnt lgkmcnt(" #n ")" ::: "memory")
#define PG8_BAR __builtin_amdgcn_s_barrier()
#define PG8_SCHED __builtin_amdgcn_sched_barrier(0)
    Unit cur, nxt; int ui = 0;
    if (!S.next(0, cur)) return;
    typedef typename Epi::AccT AccT; AccT acc[2][2][4][2];
#pragma unroll
    for (int a = 0; a < 2; ++a)
#pragma unroll
        for (int b = 0; b < 2; ++b)
#pragma unroll
            for (int m = 0; m < 4; ++m)
#pragma unroll
                for (int n = 0; n < 2; ++n) acc[a][b][m][n] = AccT{};
    bf16x8 At[4][2], B0[2][2], B1[2][2];
    const char* cA = (const char*)(cur.seg ? g.A2 : g.A) + (size_t)cur.pm * tA; const char* cB = (const char*)(cur.seg ? g.Bt2 : g.Bt) + (size_t)cur.pn * tB;
    if constexpr (SP2) {
        PG8_STAGE(PG8_SB(0, 0), cB, voffB); PG8_STAGE(PG8_SB(0, 1), cB + hB, voffB); PG8_STAGE(PG8_SA(0, 0), cA, voffA); PG8_STAGE(PG8_SA(0, 1), cA + hA, voffA);
        if (wr == 1) PG8_BAR;
        PG8_WAIT_V(2); PG8_BAR;
        PG8_STAGE(PG8_SB(1, 0), cB + kstep, voffB); PG8_STAGE(PG8_SA(1, 0), cA + kstep, voffA); PG8_STAGE(PG8_SB(1, 1), cB + hB + kstep, voffB);
        PG8_WAIT_V(6); PG8_BAR;
    } else {
        PG8_STAGE(PG8_SB(0, 0), cB, voffB); PG8_STAGE(PG8_SA(0, 0), cA, voffA); PG8_STAGE(PG8_SB(0, 1), cB + hB, voffB); PG8_STAGE(PG8_SA(0, 1), cA + hA, voffA);
        if (wr == 1) PG8_BAR;
        PG8_WAIT_V(4); PG8_BAR;
        PG8_STAGE(PG8_SB(1, 0), cB + kstep, voffB); PG8_STAGE(PG8_SA(1, 0), cA + kstep, voffA); PG8_STAGE(PG8_SB(1, 1), cB + hB + kstep, voffB);
        PG8_WAIT_V(6); PG8_BAR;
    }
    for (;;) {
        const bool has_next = S.next(ui + 1, nxt);
        const char* nA = has_next ? (const char*)(nxt.seg ? g.A2 : g.A) + (size_t)nxt.pm * tA : cA; const char* nB = has_next ? (const char*)(nxt.seg ? g.Bt2 : g.Bt) + (size_t)nxt.pn * tB : cB;
        for (int t = 0; t < nt; t += 2) {
            const bool last = (t == nt - 2);
            const char* a1 = cA + (size_t)(t + 1) * kstep;
            const char* a2 = last ? nA : cA + (size_t)(t + 2) * kstep; const char* b2 = last ? nB : cB + (size_t)(t + 2) * kstep;
            const char* a3 = a2 + kstep; const char* b3 = b2 + kstep;
            if constexpr (SP2) {
            PG8_LDB(B0, 0, 0); PG8_LDB(B1, 0, 1); PG8_SCHED; PG8_LDA(At, 0, 0); PG8_STAGE(PG8_SA(1, 1), a1 + hA, voffA);
            PG8_WAIT_V(8); PG8_WAIT_L(0); PG8_BAR; PG8_MMA(0, 0, At, B0); PG8_MMA(0, 1, At, B1); PG8_BAR; PG8_SCHED;
            PG8_LDA(At, 0, 1); PG8_STAGE(PG8_SB(0, 0), b2, voffB); PG8_STAGE(PG8_SB(0, 1), b2 + hB, voffB); PG8_STAGE(PG8_SA(0, 0), a2, voffA);
            PG8_WAIT_V(8); PG8_WAIT_L(0); PG8_BAR; PG8_MMA(1, 0, At, B0); PG8_MMA(1, 1, At, B1); PG8_BAR; PG8_SCHED;
            PG8_LDB(B0, 1, 0); PG8_LDB(B1, 1, 1); PG8_SCHED; PG8_LDA(At, 1, 0); PG8_STAGE(PG8_SA(0, 1), a2 + hA, voffA);
            PG8_WAIT_V(8); PG8_WAIT_L(0); PG8_BAR; PG8_MMA(0, 0, At, B0); PG8_MMA(0, 1, At, B1); PG8_BAR; PG8_SCHED;
            PG8_LDA(At, 1, 1); PG8_STAGE(PG8_SB(1, 0), b3, voffB); PG8_STAGE(PG8_SB(1, 1), b3 + hB, voffB); PG8_STAGE(PG8_SA(1, 0), a3, voffA);
            PG8_WAIT_V(8); PG8_WAIT_L(0); PG8_BAR; PG8_MMA(1, 0, At, B0); PG8_MMA(1, 1, At, B1); PG8_BAR; PG8_SCHED;
            } else {
            PG8_LDB(B0, 0, 0); PG8_SCHED; PG8_LDA(At, 0, 0); PG8_STAGE(PG8_SA(1, 1), a1 + hA, voffA);
            PG8_WAIT_L(8); PG8_BAR; PG8_WAIT_L(0); PG8_MMA(0, 0, At, B0); PG8_BAR; PG8_SCHED;
            PG8_LDB(B1, 0, 1); PG8_STAGE(PG8_SB(0, 0), b2, voffB);
            PG8_BAR; PG8_WAIT_L(0); PG8_MMA(0, 1, At, B1); PG8_BAR;
            PG8_LDA(At, 0, 1); PG8_STAGE(PG8_SA(0, 0), a2, voffA);
            PG8_BAR; PG8_WAIT_L(0); PG8_MMA(1, 0, At, B0); PG8_BAR; PG8_SCHED;
            PG8_STAGE(PG8_SB(0, 1), b2 + hB, voffB);
            PG8_WAIT_V(6); PG8_BAR; PG8_MMA(1, 1, At, B1); PG8_BAR;
            PG8_LDB(B0, 1, 0); PG8_SCHED; PG8_LDA(At, 1, 0); PG8_STAGE(PG8_SA(0, 1), a2 + hA, voffA);
            PG8_WAIT_L(8); PG8_BAR; PG8_WAIT_L(0); PG8_MMA(0, 0, At, B0); PG8_BAR; PG8_SCHED;
            PG8_LDB(B1, 1, 1); PG8_STAGE(PG8_SB(1, 0), b3, voffB);
            PG8_BAR; PG8_WAIT_L(0); PG8_MMA(0, 1, At, B1); PG8_BAR;
            PG8_LDA(At, 1, 1); PG8_STAGE(PG8_SA(1, 0), a3, voffA);
            PG8_BAR; PG8_WAIT_L(0); PG8_MMA(1, 0, At, B0); PG8_BAR; PG8_SCHED;
            PG8_STAGE(PG8_SB(1, 1), b3 + hB, voffB);
            PG8_WAIT_V(6); PG8_BAR; PG8_MMA(1, 1, At, B1); PG8_BAR;
            }
        }
        if constexpr (ALIGN_EPI) { if (wr == 0) PG8_BAR; }
        E(acc, cur, wr, wc, fr, fq);
        if (!has_next) break;
        if (!Epi::keep_acc(cur))
#pragma unroll
        for (int a = 0; a < 2; ++a)
#pragma unroll
            for (int b = 0; b < 2; ++b)
#pragma unroll
                for (int m = 0; m < 4; ++m)
#pragma unroll
                    for (int n = 0; n < 2; ++n) acc[a][b][m][n] = AccT{};
        cur = nxt; cA = nA; cB = nB; ++ui;
        if constexpr (ALIGN_EPI) { if (wr == 1) PG8_BAR; }
    }
    PG8_WAIT_V(0);
    if constexpr (!ALIGN_EPI) { if (wr == 0) PG8_BAR; }
    PG8_BAR;
#undef PG8_SA
#undef PG8_SB
#undef PG8_STAGE
#undef PG8_LDA
#undef PG8_LDB
#undef PG8_MMA
#undef PG8_WAIT_V
#undef PG8_WAIT_L
#undef PG8_BAR
#undef PG8_SCHED
}
}

namespace att {
constexpr int SHM_V = 16384, SHM_K = 16384;
constexpr int OFF_V = 0, OFF_K = 3 * SHM_V, OFF_WS = OFF_K + 3 * SHM_K, OFF_TBL = OFF_WS + 8 * 256 + 1024;
#define KSWZ(row, colB) ((row) * 256 + ((colB) ^ (((row) & 7) << 4)))
#define SBAR() __builtin_amdgcn_sched_barrier(0)
__device__ __forceinline__ int crow(int r, int hi) { return (r & 3) + 8 * (r >> 2) + 4 * hi; }
__device__ __forceinline__ int v_st(int k, int c) { const int kk = (k & ~0xC) | ((k & 4) << 1) | ((k & 8) >> 1); return ((kk >> 3) * 4 + (c >> 5)) * 512 + ((kk & 7) * 32 + (c & 31)) * 2; }
__device__ __forceinline__ int v_rd_base(int lane) { return ((lane & 3) << 3) | (((lane >> 2) & 3) << 6) | (((lane >> 4) & 1) << 5) | (((lane >> 5) & 1) << 8); }
constexpr int v_rd_off(int d0, int ks, int half) { return d0 * 512 + ks * 4096 + half * 2048; }
template <int OFF> __device__ __forceinline__ s16x4 tr_read(int vb) {
    s16x4 r; asm volatile("ds_read_b64_tr_b16 %0, %1 offset:%2" : "=&v"(r) : "v"(vb), "i"(OFF) : "memory"); return r;
}
#define PK(L, H) (bf16x8){L[0], L[1], L[2], L[3], H[0], H[1], H[2], H[3]}
struct VFrag { s16x4 l0, h0, l1, h1, l2, h2, l3, h3; };
template <int D0> __device__ __forceinline__ void pv_reads(VFrag& f, int vb) {
    f.l0 = tr_read<v_rd_off(D0, 0, 0)>(vb); f.h0 = tr_read<v_rd_off(D0, 0, 1)>(vb); f.l1 = tr_read<v_rd_off(D0, 1, 0)>(vb); f.h1 = tr_read<v_rd_off(D0, 1, 1)>(vb);
    f.l2 = tr_read<v_rd_off(D0, 2, 0)>(vb); f.h2 = tr_read<v_rd_off(D0, 2, 1)>(vb); f.l3 = tr_read<v_rd_off(D0, 3, 0)>(vb); f.h3 = tr_read<v_rd_off(D0, 3, 1)>(vb);
}
__device__ __forceinline__ void pv_mma(f32x16& od, const VFrag& f, bf16x8 pa0, bf16x8 pa1, bf16x8 pa2, bf16x8 pa3) {
    od = __builtin_amdgcn_mfma_f32_32x32x16_bf16(pa0, PK(f.l0, f.h0), od, 0, 0, 0);
    od = __builtin_amdgcn_mfma_f32_32x32x16_bf16(pa1, PK(f.l1, f.h1), od, 0, 0, 0);
    od = __builtin_amdgcn_mfma_f32_32x32x16_bf16(pa2, PK(f.l2, f.h2), od, 0, 0, 0);
    od = __builtin_amdgcn_mfma_f32_32x32x16_bf16(pa3, PK(f.l3, f.h3), od, 0, 0, 0);
}
__device__ __forceinline__ void pv_all(f32x16 (&o)[4], int vb, bf16x8 pa0, bf16x8 pa1, bf16x8 pa2, bf16x8 pa3) {
    VFrag fa, fb;
    pv_reads<0>(fa, vb); pv_reads<1>(fb, vb);
    asm volatile("s_waitcnt lgkmcnt(8)" ::: "memory"); SBAR(); pv_mma(o[0], fa, pa0, pa1, pa2, pa3); SBAR();
    pv_reads<2>(fa, vb);
    asm volatile("s_waitcnt lgkmcnt(8)" ::: "memory"); SBAR(); pv_mma(o[1], fb, pa0, pa1, pa2, pa3); SBAR();
    pv_reads<3>(fb, vb);
    asm volatile("s_waitcnt lgkmcnt(8)" ::: "memory"); SBAR(); pv_mma(o[2], fa, pa0, pa1, pa2, pa3); SBAR();
    asm volatile("s_waitcnt lgkmcnt(0)" ::: "memory"); SBAR(); pv_mma(o[3], fb, pa0, pa1, pa2, pa3);
}
#undef PK
template <bool ISB>
__device__ __forceinline__ void attn_unit(LAS unsigned char* lds, const bf16_t* __restrict__ QKVG, bf16_t* __restrict__ OAB, const float* __restrict__ sink, const float* __restrict__ rpb,
                                          int b, int hh, int blk) {
    int tid = threadIdx.x; asm volatile("" : "+v"(tid));
    const int wid = __builtin_amdgcn_readfirstlane(tid >> 6), lane = tid & 63, r32 = lane & 31, hi = lane >> 5;
    LAS unsigned char* V_lds = lds + OFF_V; LAS unsigned char* K_lds = lds + OFF_K;
    LAS float* wsc = (LAS float*)(lds + OFF_WS) + wid * 64;
    LAS float* tbl = (LAS float*)(lds + OFF_TBL);
    int qrow0, qcol, kcol, vcol, ocol, nt, lat0;
    int qoff = (wid & 1) * 32 + r32;
    int rq = 0, wlo = 0;
    if (ISB) {
        const int r0 = blk * 4; rq = r0 + (wid >> 1); wlo = min(max(rq - 4, 0), 120);
        const int kr0 = min(max(r0 - 4, 0), 120), kr1 = min(max(r0 + 3 - 4, 0), 120) + 8;
        lat0 = kr0; nt = 4 + (kr1 - kr0);
        qrow0 = b * SEQ + rq * 64 + (wid & 1) * 32; qcol = C_QB + hh * 128; kcol = C_KB + hh * 128; vcol = C_VB + hh * 128; ocol = 1024 + hh * 128;
    } else {
        const int t0 = blk * 64; const int jl0 = t0 >= 128 ? 0 : (128 - t0) / 64; const int jl1 = min(5, (SEQ + 128 - t0) / 64);
        lat0 = jl0; nt = 4 + (jl1 - jl0);
        const int head = hh * 4 + (wid >> 1);
        qrow0 = b * SEQ + t0 + (wid & 1) * 32; qcol = C_QA + head * 128; kcol = C_KA + hh * 128; vcol = C_VA + hh * 128; ocol = head * 128;
    }
    auto tile_row = [&](int i) -> int {
        if (i < 4) return MTOK + b * CTXL + 64 * i;
        if (ISB) return b * SEQ + (lat0 + i - 4) * 64;
        return b * SEQ + blk * 64 - 128 + 64 * (lat0 + i - 4);
    };
    bf16x8 qr[8];
    { const bf16_t* Qw = QKVG + (size_t)(qrow0 + r32) * DIN + qcol + hi * 8;
#pragma unroll
      for (int d0 = 0; d0 < 8; ++d0) qr[d0] = *(const bf16x8*)(Qw + d0 * 16); }
    float m_reg, l_reg;
    if (ISB) { m_reg = NEGBIG; l_reg = 0.f; for (int i = tid; i < 465; i += 512) tbl[i] = rpb[hh * 465 + i] * LOG2E; }
    else { m_reg = sink[hh * 4 + (wid >> 1)] * LOG2E; l_reg = 1.f; }
    f32x16 o[4];
#pragma unroll
    for (int d = 0; d < 4; ++d)
#pragma unroll
        for (int r = 0; r < 16; ++r) o[d][r] = 0.f;
    const int vb0 = (int)(uintptr_t)V_lds + v_rd_base(lane);
    unsigned koff[2], voff[2];
#pragma unroll
    for (int i = 0; i < 2; ++i) { const int g = (i * 8 + wid) * 64 + lane;
        { const int row = g >> 4, c = (g & 15) ^ (row & 7); koff[i] = (unsigned)(row * DIN + c * 8) * 2u; }
        { const int sub = g >> 5, kk = (sub >> 2) * 8 + ((g >> 2) & 7), c = (sub & 3) * 32 + (g & 3) * 8, k = (kk & ~0xC) | ((kk & 4) << 1) | ((kk & 8) >> 1); voff[i] = (unsigned)(k * DIN + c) * 2u; } }
    const unsigned ldsw = (unsigned)wid * 1024u;
    const int kb0 = r32 * 256 + (((0 + hi) ^ (r32 & 7)) << 4), kb1 = r32 * 256 + (((2 + hi) ^ (r32 & 7)) << 4), kb2 = r32 * 256 + (((4 + hi) ^ (r32 & 7)) << 4), kb3 = r32 * 256 + (((6 + hi) ^ (r32 & 7)) << 4);
#define SSTAGE(R0, bb) do { const char* gk_ = (const char*)(QKVG + (size_t)(R0) * DIN + kcol); const char* gv_ = (const char*)(QKVG + (size_t)(R0) * DIN + vcol); \
        _Pragma("unroll") for (int _i = 0; _i < 2; ++_i) { \
            __builtin_amdgcn_global_load_lds((const unsigned*)(gk_ + koff[_i]), (LAS unsigned*)(K_lds + (bb) * SHM_K + ldsw + _i * 8192), 16, 0, 0); \
            __builtin_amdgcn_global_load_lds((const unsigned*)(gv_ + voff[_i]), (LAS unsigned*)(V_lds + (bb) * SHM_V + ldsw + _i * 8192), 16, 0, 0); } } while (0)
#define PK4(P, BASE, OUT) do { unsigned a0 = cvt_pk_bf16(P[BASE + 0], P[BASE + 1]), a1 = cvt_pk_bf16(P[BASE + 2], P[BASE + 3]);   \
    unsigned b0 = cvt_pk_bf16(P[BASE + 4], P[BASE + 5]), b1 = cvt_pk_bf16(P[BASE + 6], P[BASE + 7]);                              \
    auto r0 = __builtin_amdgcn_permlane32_swap(a0, b0, false, false); auto r1 = __builtin_amdgcn_permlane32_swap(a1, b1, false, false); \
    u32x4 w = {r0[0], r1[0], r0[1], r1[1]}; OUT = *reinterpret_cast<bf16x8*>(&w); } while (0)
#define ATT_FINISH(VS) do { \
        float pmax = p0[0]; \
        _Pragma("unroll") for (int r = 1; r < 16; ++r) pmax = fmaxf(pmax, p0[r]); \
        _Pragma("unroll") for (int r = 0; r < 16; ++r) pmax = fmaxf(pmax, p1[r]); \
        { auto rr = __builtin_amdgcn_permlane32_swap(__float_as_uint(pmax), __float_as_uint(pmax), false, false); \
          pmax = fmaxf(__uint_as_float(rr[0]), __uint_as_float(rr[1])); } \
        if (!__all(pmax - m_reg <= 8.0f)) { \
            const float mn = fmaxf(m_reg, pmax); const float alpha = __builtin_amdgcn_exp2f(m_reg - mn); m_reg = mn; l_reg *= alpha; \
            if (hi == 0) wsc[r32] = alpha; asm volatile("s_waitcnt lgkmcnt(0)" ::: "memory"); \
            _Pragma("unroll") for (int r = 0; r < 16; ++r) { const float al = wsc[crow(r, hi)]; \
                _Pragma("unroll") for (int d = 0; d < 4; ++d) o[d][r] *= al; } \
            asm volatile("s_waitcnt lgkmcnt(0)" ::: "memory"); } \
        float ps = 0.f; \
        _Pragma("unroll") for (int r = 0; r < 16; ++r) { p0[r] = __builtin_amdgcn_exp2f(p0[r] - m_reg); ps += p0[r]; } \
        _Pragma("unroll") for (int r = 0; r < 16; ++r) { p1[r] = __builtin_amdgcn_exp2f(p1[r] - m_reg); ps += p1[r]; } \
        { auto rr = __builtin_amdgcn_permlane32_swap(__float_as_uint(ps), __float_as_uint(ps), false, false); \
          ps = __uint_as_float(rr[0]) + __uint_as_float(rr[1]); } \
        l_reg += ps; \
        bf16x8 pa0, pa1, pa2, pa3; \
        PK4(p0, 0, pa0); PK4(p0, 8, pa1); PK4(p1, 0, pa2); PK4(p1, 8, pa3); \
        pv_all(o, vb0 + (VS) * SHM_V, pa0, pa1, pa2, pa3); } while (0)
    SSTAGE(tile_row(0), 0); asm volatile("s_waitcnt vmcnt(0) lgkmcnt(0)" ::: "memory"); __builtin_amdgcn_s_barrier(); asm volatile("" ::: "memory");
    const bool late = wid >= 4; bool pending = false; int bprev = 0;
    f32x16 p0, p1;
#pragma unroll
    for (int r = 0; r < 16; ++r) { p0[r] = 0.f; p1[r] = 0.f; }
    int bb = 0, bn = 1;
    for (int i = 0; i < nt; ++i) {
        if (i + 1 < nt) SSTAGE(tile_row(i + 1), bn);
        if (late && pending) { ATT_FINISH(bprev); pending = false; }
        bool active = true; int dr = 0, mmode = 0;
        if (ISB) { if (i >= 4) { const int kr = lat0 + i - 4; active = (kr >= wlo) && (kr < wlo + 8); dr = kr - rq + 7; } }
        else { if (i >= 4) { const int jl = lat0 + i - 4; mmode = jl == 0 ? 1 : (jl == 4 ? 2 : 0); } }
        if (active) {
#pragma unroll
            for (int r = 0; r < 16; ++r) { p0[r] = 0.f; p1[r] = 0.f; }
            const LAS unsigned char* Ks = K_lds + bb * SHM_K;
#define KADDR(d0) (Ks + (((d0) & 3) == 0 ? kb0 : ((d0) & 3) == 1 ? kb1 : ((d0) & 3) == 2 ? kb2 : kb3) + ((d0) >> 2) * 128)
#define LOADG(F, g) do { F[0] = *(const LAS bf16x8*)(KADDR(2 * (g))); F[1] = *(const LAS bf16x8*)(KADDR(2 * (g)) + 8192); F[2] = *(const LAS bf16x8*)(KADDR(2 * (g) + 1)); F[3] = *(const LAS bf16x8*)(KADDR(2 * (g) + 1) + 8192); } while (0)
#define MMAG(F, g) do { p0 = __builtin_amdgcn_mfma_f32_32x32x16_bf16(F[0], qr[2 * (g)], p0, 0, 0, 0); p1 = __builtin_amdgcn_mfma_f32_32x32x16_bf16(F[1], qr[2 * (g)], p1, 0, 0, 0); \
                p0 = __builtin_amdgcn_mfma_f32_32x32x16_bf16(F[2], qr[2 * (g) + 1], p0, 0, 0, 0); p1 = __builtin_amdgcn_mfma_f32_32x32x16_bf16(F[3], qr[2 * (g) + 1], p1, 0, 0, 0); } while (0)
            { bf16x8 fa[4], fb[4];
              LOADG(fa, 0); LOADG(fb, 1); SBAR();
              MMAG(fa, 0); SBAR(); LOADG(fa, 2); SBAR();
              MMAG(fb, 1); SBAR(); LOADG(fb, 3); SBAR();
              MMAG(fa, 2); SBAR();
              MMAG(fb, 3); SBAR(); }
#undef KADDR
#undef LOADG
#undef MMAG
            int hi4 = 4 * hi; asm volatile("" : "+v"(hi4));
            if (ISB) {
                if (i >= 4) { int qo_ = qoff; asm volatile("" : "+v"(qo_)); const int cs = min(max(qo_ - 8, 0), 48); const LAS float* tb = tbl + dr * 31 + 15 - qo_;
#pragma unroll
                    for (int r = 0; r < 16; ++r) { const int c0 = crow(r, 0) + hi4, c1 = 32 + c0;
                        const float b0 = tb[c0], b1 = tb[c1];
                        p0[r] = ((unsigned)(c0 - cs) < 16u) ? p0[r] + b0 : NEGBIG;
                        p1[r] = ((unsigned)(c1 - cs) < 16u) ? p1[r] + b1 : NEGBIG; } }
            } else {
                int qo_ = qoff; asm volatile("" : "+v"(qo_));
                if (mmode == 1) {
#pragma unroll
                    for (int r = 0; r < 16; ++r) { const int c0 = crow(r, 0) + hi4, c1 = 32 + c0; p0[r] = c0 >= qo_ ? p0[r] : NEGBIG; p1[r] = c1 >= qo_ ? p1[r] : NEGBIG; } }
                else if (mmode == 2) {
#pragma unroll
                    for (int r = 0; r < 16; ++r) { const int c0 = crow(r, 0) + hi4, c1 = 32 + c0; p0[r] = c0 <= qo_ ? p0[r] : NEGBIG; p1[r] = c1 <= qo_ ? p1[r] : NEGBIG; } }
            }
            if (!late) { ATT_FINISH(bb); } else { pending = true; bprev = bb; }
        }
        asm volatile("s_waitcnt vmcnt(0) lgkmcnt(0)" ::: "memory");
        __builtin_amdgcn_s_barrier(); asm volatile("" ::: "memory");
        bb = bb == 2 ? 0 : bb + 1; bn = bn == 2 ? 0 : bn + 1;
    }
    if (late && pending) { ATT_FINISH(bprev); }
#undef ATT_FINISH
#undef PK4
#undef SSTAGE
    if (hi == 0) wsc[r32] = l_reg; asm volatile("s_waitcnt lgkmcnt(0)" ::: "memory");
    bf16_t* Ow = OAB + (size_t)qrow0 * DM + ocol;
#pragma unroll
    for (int r = 0; r < 16; ++r) { const int orow = crow(r, hi); const float rl = __builtin_amdgcn_rcpf(wsc[orow]);
#pragma unroll
        for (int d0 = 0; d0 < 4; ++d0) { const unsigned w = cvt_pk_bf16(o[d0][r] * rl, 0.f); Ow[(size_t)orow * DM + d0 * 32 + r32] = (bf16_t)(w & 0xffffu); } }
    asm volatile("s_waitcnt lgkmcnt(0)" ::: "memory");
    __syncthreads();
}
}

template <int MODE> __device__ __forceinline__ int dest_row(int o) {
    if (MODE == 1) { if (o >= C_VA) return o; const int base = o & ~63, w = o & 63; return base + (w < 32 ? 8 * (w >> 2) + (w & 3) : 8 * ((w - 32) >> 2) + 4 + (w & 3)); }
    if (MODE == 2) { if (o < DFF) return 256 * (o >> 7) + (o & 127); const int q = o - DFF; return 256 * (q >> 7) + 128 + (q & 127); }
    return o;
}
template <int MODE> __device__ __forceinline__ void p0_transpose_item(const float* __restrict__ W, int K, int N, bf16_t* __restrict__ WT, LAS float* scr, int item, int lane) {
    const int nblk = N / 32, kb = item / nblk, nb = item % nblk, k0 = 64 * kb, n0 = 32 * nb;
    float tv[32];
#pragma unroll
    for (int i = 0; i < 32; ++i) { const int kk = 2 * i + (lane >> 5); tv[i] = __builtin_nontemporal_load(W + (size_t)(k0 + kk) * N + n0 + (lane & 31)); }
#pragma unroll
    for (int i = 0; i < 32; ++i) { const int kk = 2 * i + (lane >> 5); scr[kk * 33 + (lane & 31)] = tv[i]; }
    asm volatile("s_waitcnt lgkmcnt(0)" ::: "memory");
    const int c = lane & 7;
#pragma unroll
    for (int j = 0; j < 4; ++j) { const int n = (lane >> 3) + 8 * j; const LAS float* s = scr + (8 * c) * 33 + n;
        u32x4 o; o.x = cvt_pk_bf16(s[0 * 33], s[1 * 33]); o.y = cvt_pk_bf16(s[2 * 33], s[3 * 33]); o.z = cvt_pk_bf16(s[4 * 33], s[5 * 33]); o.w = cvt_pk_bf16(s[6 * 33], s[7 * 33]);
        *(u32x4*)(WT + (size_t)dest_row<MODE>(n0 + n) * K + k0 + 8 * c) = o; }
    asm volatile("s_waitcnt lgkmcnt(0)" ::: "memory");
}

struct Args { const float* in[20]; float* out; unsigned char* ws; int ph_lo, ph_hi; };
enum { I_X = 0, I_C, I_CTX, I_CCTX, I_WMOD, I_BMOD, I_GAPRE, I_GAPOST, I_GFPRE, I_GFPOST, I_WIN, I_SINK, I_RPB, I_WBA, I_WBB, I_WO, I_WUP, I_CONVW, I_CONVB, I_WDN };
constexpr int NPHASE = 11;

__global__ void __launch_bounds__(512, 2) fwd_mega(Args args) {
    extern __shared__ __attribute__((aligned(16))) unsigned char lds_raw[];
    LAS unsigned char* lds = (LAS unsigned char*)lds_raw;
    cg::grid_group grid = cg::this_grid();
    const int tid = threadIdx.x, lane = tid & 63, wave = __builtin_amdgcn_readfirstlane(tid >> 6);
    const int G = gridDim.x, bid = blockIdx.x;
    const int gw = bid * 8 + wave, NGW = G * 8;
    unsigned char* ws = args.ws;
    float* MOD = (float*)(ws + WS_MOD); float* ROPEC = (float*)(ws + WS_ROPEC); float* ROPES = (float*)(ws + WS_ROPES);
    bf16_t* WIN = (bf16_t*)(ws + WS_WIN); bf16_t* WBA = (bf16_t*)(ws + WS_WBA); bf16_t* WBB = (bf16_t*)(ws + WS_WBB); bf16_t* WO = (bf16_t*)(ws + WS_WO);
    bf16_t* WUP = (bf16_t*)(ws + WS_WUP); bf16_t* WDN = (bf16_t*)(ws + WS_WDN);
    float* SA = (float*)(ws + WS_SA); float* SB = (float*)(ws + WS_SB); unsigned* CM = (unsigned*)(ws + WS_CM);
    bf16_t* H = (bf16_t*)(ws + WS_H); bf16_t* Z = H; bf16_t* F = H;
    bf16_t* OAB = (bf16_t*)(ws + WS_OAB); bf16_t* H2 = OAB;
    bf16_t* QKVG = (bf16_t*)(ws + WS_QKVG); bf16_t* Y = (bf16_t*)(ws + WS_Y); bf16_t* ACT = (bf16_t*)(ws + WS_ACT); bf16_t* HALO = (bf16_t*)(ws + WS_HALO);
    const int lo = args.ph_lo, hi_ph = args.ph_hi;
    volatile LAS unsigned* MISC = (volatile LAS unsigned*)(lds + 131072 + 320);
    if (tid < 32) MISC[tid] = 0u;
    __syncthreads();
    XcdBarrier xbar = xcd_barrier_post((unsigned*)(ws + WS_BAR), MISC + 8);
#ifndef REPMASK
#define REPMASK 0
#endif
#define NREP(k) ((((REPMASK) >> (k)) & 1) ? 2 : 1)
#define IN(k) (lo <= (k) && (k) < hi_ph)
#define SEAM(k) do { if (IN(k) && IN((k) + 1)) xcd_barrier(xbar); } while (0)
    if (args.ph_lo > NPHASE) grid.sync();

    for (int rep_ = 0; rep_ < NREP(0); ++rep_) if (IN(0)) {
        int tid = threadIdx.x; asm volatile("" : "+v"(tid)); const int lane = tid & 63; (void)lane;
        LAS float* sl = (LAS float*)lds;
        LAS float* red = sl + 5 * DM;
        const float* c = args.in[I_C]; const float* cctx = args.in[I_CCTX];
        for (int i = tid; i < 5 * DM; i += 512) { const int b = i / DM, k = i % DM; const float v = b < 4 ? c[b * DM + k] : cctx[k]; sl[i] = v / (1.0f + __expf(-v)); }
        __syncthreads();
        const float* wmod = args.in[I_WMOD]; const float* bmod = args.in[I_BMOD];
        for (int item = bid; item < NMOD / 32; item += G) {
            const int n0 = item * 32, cn = tid & 31, kg = tid >> 5;
            float a0 = 0.f, a1 = 0.f, a2 = 0.f, a3 = 0.f, a4 = 0.f;
            const float* wp = wmod + (size_t)(kg * 128) * NMOD + n0 + cn; const LAS float* sp = sl + kg * 128;
#pragma unroll 32
            for (int kk = 0; kk < 128; ++kk) { const float w = __builtin_nontemporal_load(wp + (size_t)kk * NMOD);
                a0 += sp[kk] * w; a1 += sp[DM + kk] * w; a2 += sp[2 * DM + kk] * w; a3 += sp[3 * DM + kk] * w; a4 += sp[4 * DM + kk] * w; }
            LAS float* rp = red + (kg * 32 + cn) * 5; rp[0] = a0; rp[1] = a1; rp[2] = a2; rp[3] = a3; rp[4] = a4;
            __syncthreads();
            if (tid < 160) { const int b = tid >> 5, cn2 = tid & 31; float s = 0.f;
#pragma unroll
                for (int q = 0; q < 16; ++q) s += red[(q * 32 + cn2) * 5 + b];
                MOD[b * NMOD + n0 + cn2] = s + bmod[n0 + cn2]; }
            __syncthreads();
        }
        for (int i = bid * 512 + tid; i < 128 * 32; i += G * 512) { const int pos = i >> 5, j = i & 31;
            const float inv = powf(10000.0f, -(float)j / 32.0f); const float ang = (float)pos * inv; ROPEC[i] = cosf(ang); ROPES[i] = sinf(ang); }
        __syncthreads();
        LAS float* scr = (LAS float*)(lds + wave * 16384);
        constexpr int I_IN = (DM / 64) * (DIN / 32), I_BR = (1024 / 64) * (DM / 32), I_O = (DM / 64) * (DM / 32), I_UP = (DM / 64) * (DUP / 32), I_DN = (DFF / 64) * (DM / 32);
        constexpr int NITEMS = I_IN + 2 * I_BR + I_O + I_UP + I_DN;
        for (int it = gw; it < NITEMS; it += NGW) {
            int r = it;
            if (r < I_IN) { p0_transpose_item<1>(args.in[I_WIN], DM, DIN, WIN, scr, r, lane); continue; } r -= I_IN;
            if (r < I_BR) { p0_transpose_item<0>(args.in[I_WBA], 1024, DM, WBA, scr, r, lane); continue; } r -= I_BR;
            if (r < I_BR) { p0_transpose_item<0>(args.in[I_WBB], 1024, DM, WBB, scr, r, lane); continue; } r -= I_BR;
            if (r < I_O) { p0_transpose_item<0>(args.in[I_WO], DM, DM, WO, scr, r, lane); continue; } r -= I_O;
            if (r < I_UP) {
                const float* W = args.in[I_WUP]; const int nblk = DUP / 32, kb = r / nblk, nb = r % nblk, k0 = 64 * kb, n0 = 32 * nb; float mx = 0.f;
#pragma unroll
                for (int i = 0; i < 32; ++i) { const int kk = 2 * i + (lane >> 5); mx = fmaxf(mx, fabsf(__builtin_nontemporal_load(W + (size_t)(k0 + kk) * DUP + n0 + (lane & 31)))); }
                mx = fmaxf(mx, __shfl_xor(mx, 32));
                if (lane < 32) atomicMax(CM + dest_row<2>(n0 + lane), __float_as_uint(mx));
                continue; } r -= I_UP;
            p0_transpose_item<0>(args.in[I_WDN], DFF, DM, WDN, scr, r, lane);
        }
        __syncthreads();
    }
    SEAM(0);

    for (int rep_ = 0; rep_ < NREP(1); ++rep_) if (IN(1)) {
        int tid = threadIdx.x; asm volatile("" : "+v"(tid)); const int lane = tid & 63; (void)lane;
        {
            LAS float* scr = (LAS float*)(lds + wave * 16384);
            const float* W = args.in[I_WUP]; unsigned char* W8 = (unsigned char*)WUP;
            constexpr int NI = (DM / 64) * (DUP / 32);
            for (int it = gw; it < NI; it += NGW) {
                const int nblk = DUP / 32, kb = it / nblk, nb = it % nblk, k0 = 64 * kb, n0 = 32 * nb;
                float tv[32];
#pragma unroll
                for (int i = 0; i < 32; ++i) { const int kk = 2 * i + (lane >> 5); tv[i] = __builtin_nontemporal_load(W + (size_t)(k0 + kk) * DUP + n0 + (lane & 31)); }
#pragma unroll
                for (int i = 0; i < 32; ++i) { const int kk = 2 * i + (lane >> 5); scr[kk * 33 + (lane & 31)] = tv[i]; }
                asm volatile("s_waitcnt lgkmcnt(0)" ::: "memory");
#pragma unroll
                for (int ps = 0; ps < 2; ++ps) { const int n = (lane >> 2) + 16 * ps, kq = lane & 3; const int dest = dest_row<2>(n0 + n);
                    const float cmax = __uint_as_float(CM[dest]); const float inv = cmax > 0.f ? 127.0f / cmax : 0.f;
                    const LAS float* sp = scr + (16 * kq) * 33 + n;
                    u32x4 o;
                    o.x = pack_i8x4(sp[0 * 33] * inv, sp[1 * 33] * inv, sp[2 * 33] * inv, sp[3 * 33] * inv);
                    o.y = pack_i8x4(sp[4 * 33] * inv, sp[5 * 33] * inv, sp[6 * 33] * inv, sp[7 * 33] * inv);
                    o.z = pack_i8x4(sp[8 * 33] * inv, sp[9 * 33] * inv, sp[10 * 33] * inv, sp[11 * 33] * inv);
                    o.w = pack_i8x4(sp[12 * 33] * inv, sp[13 * 33] * inv, sp[14 * 33] * inv, sp[15 * 33] * inv);
                    *(u32x4*)(W8 + (size_t)dest * DM + k0 + 16 * kq) = o;
                    if (kb == 0 && kq == 0) SB[dest] = cmax * (1.0f / 127.0f); }
                asm volatile("s_waitcnt lgkmcnt(0)" ::: "memory");
            }
        }
        const float* x = args.in[I_X]; const float* ctx = args.in[I_CTX]; const float* g = args.in[I_GAPRE];
#define P1_LOAD(V, R) do { const f32x4* xr_ = (const f32x4*)(srcb + (size_t)(R) * DM) + lane; \
        _Pragma("unroll") for (int j = 0; j < 8; ++j) V[j] = __builtin_nontemporal_load(xr_ + 64 * j); } while (0)
#define P1_PROC(V, R) do { float ss_ = 0.f; \
        _Pragma("unroll") for (int j = 0; j < 8; ++j) ss_ += (V[j].x * V[j].x + V[j].y * V[j].y) + (V[j].z * V[j].z + V[j].w * V[j].w); \
        const float rstd_ = 1.0f / sqrtf(wave_sum(ss_) * (1.0f / DM) + EPS); u32x2* hr_ = (u32x2*)(H + (row0 + (size_t)(R)) * DM) + lane; \
        _Pragma("unroll") for (int j = 0; j < 8; ++j) { const f32x4 hv = (V[j] * rstd_) * PA[j] + PB[j]; \
            u32x2 w; w.x = cvt_pk_bf16(hv.x, hv.y); w.y = cvt_pk_bf16(hv.z, hv.w); hr_[64 * j] = w; } } while (0)
        for (int b = 0; b < 5; ++b) {
            const int nrows = b < 4 ? SEQ : MCTX; const size_t row0 = b < 4 ? (size_t)b * SEQ : (size_t)MTOK;
            const float* srcb = b < 4 ? x + (size_t)b * SEQ * DM : ctx; const float* mb = MOD + b * NMOD;
            f32x4 PA[8], PB[8];
#pragma unroll
            for (int j = 0; j < 8; ++j) { const int col = 4 * (lane + 64 * j); PA[j] = *(const f32x4*)(g + col) * (*(const f32x4*)(mb + DM + col) + 1.0f); PB[j] = *(const f32x4*)(mb + col); }
            f32x4 va[8], vb[8]; int r = gw;
            if (r < nrows) P1_LOAD(va, r);
            for (; r < nrows; r += 2 * NGW) {
                const int r2 = r + NGW, r3 = r2 + NGW;
                if (r2 < nrows) P1_LOAD(vb, r2);
                P1_PROC(va, r);
                if (r3 < nrows) P1_LOAD(va, r3);
                if (r2 < nrows) P1_PROC(vb, r2);
            }
        }
#undef P1_LOAD
#undef P1_PROC
    }
    SEAM(1);

    for (int rep_ = 0; rep_ < NREP(2); ++rep_) if (IN(2)) {
        pg8::Gemm g{H, WIN, DM, DM, DM, H, WIN}; pg8::Order S; S.init(MTOK / 256, DIN / 256, G, bid, 40);
        pg8::EpiQKV E{QKVG, ROPEC, ROPES};
        pg8::gemm_phase<pg8::EpiQKV, pg8::Order, true, true>(lds, g, S, E);
    }
    SEAM(2);

    for (int rep_ = 0; rep_ < NREP(3); ++rep_) if (IN(3)) {
        const float* sink = args.in[I_SINK]; const float* rpb = args.in[I_RPB];
#ifndef ATT_REP
#define ATT_REP 1
#endif
        const int vcu = (G % 8 == 0) ? (bid & 7) * (G >> 3) + (bid >> 3) : bid;
        for (int i0 = 0; i0 * G + vcu < 2048 * ATT_REP; ++i0) { const int i = i0 & 7;
            const int idx = (i >> 1) * G + vcu;
            if (idx >= 1024) continue;
            if (i & 1) { const int b = idx >> 8, h = (idx >> 5) & 7, rb = idx & 31; att::attn_unit<true>(lds, QKVG, OAB, sink, rpb, b, h, rb); }
            else { const int b = idx >> 8, kvh = (idx >> 7) & 1, blk = idx & 127; att::attn_unit<false>(lds, QKVG, OAB, sink, rpb, b, kvh, blk); }
        }
    }
    SEAM(3);

    for (int rep_ = 0; rep_ < NREP(4); ++rep_) if (IN(4)) {
        pg8::Gemm g{OAB, WBA, DM, 1024, 1024, OAB + 1024, WBB}; pg8::Order S; S.init(MTOK / 256, DM / 256, G, bid, 0, 1);
        pg8::EpiBranch2 E{Z, QKVG + C_GA, QKVG + C_GB};
        pg8::gemm_phase<pg8::EpiBranch2, pg8::Order, true, true>(lds, g, S, E);
    }
    SEAM(4);

    for (int rep_ = 0; rep_ < NREP(5); ++rep_) if (IN(5)) {
        pg8::Gemm g{Z, WO, DM, DM, DM, Z, WO}; pg8::Order S; S.init(MTOK / 256, DM / 256, G, bid, 0);
        pg8::EpiBf16 E{Y, DM};
        pg8::gemm_phase<pg8::EpiBf16, pg8::Order, true, true>(lds, g, S, E);
    }
    SEAM(5);

    for (int rep_ = 0; rep_ < NREP(6); ++rep_) if (IN(6)) {
        int tid = threadIdx.x; asm volatile("" : "+v"(tid)); const int lane = tid & 63; (void)lane;
        const float* x = args.in[I_X]; const float* gpost = args.in[I_GAPOST]; const float* gpre = args.in[I_GFPRE];
#define P6_LOAD(VX, VY, M) do { const f32x4* xr_ = (const f32x4*)(x + (size_t)(M) * DM) + lane; const u32x2* yr_ = (const u32x2*)(Y + (size_t)(M) * DM) + lane; \
        _Pragma("unroll") for (int j = 0; j < 8; ++j) VY[j] = yr_[64 * j]; \
        _Pragma("unroll") for (int j = 0; j < 8; ++j) VX[j] = __builtin_nontemporal_load(xr_ + 64 * j); } while (0)
#define P6_PROC(VX, VY, M) do { float ss_ = 0.f; \
        _Pragma("unroll") for (int j = 0; j < 8; ++j) { const float y0 = bf_lo(VY[j].x), y1 = bf_hi(VY[j].x), y2 = bf_lo(VY[j].y), y3 = bf_hi(VY[j].y); ss_ += (y0 * y0 + y1 * y1) + (y2 * y2 + y3 * y3); } \
        const float rstd_ = 1.0f / sqrtf(wave_sum(ss_) * (1.0f / DM) + EPS); float s2_ = 0.f; \
        _Pragma("unroll") for (int j = 0; j < 8; ++j) { \
            const f32x4 yv = {bf_lo(VY[j].x), bf_hi(VY[j].x), bf_lo(VY[j].y), bf_hi(VY[j].y)}; \
            VX[j] = VX[j] + A1[j] * (yv * rstd_); \
            s2_ += (VX[j].x * VX[j].x + VX[j].y * VX[j].y) + (VX[j].z * VX[j].z + VX[j].w * VX[j].w); } \
        const float rstd2_ = 1.0f / sqrtf(wave_sum(s2_) * (1.0f / DM) + EPS); float hm_ = 0.f; \
        _Pragma("unroll") for (int j = 0; j < 8; ++j) { const f32x4 hv = (VX[j] * rstd2_) * A2[j] + B2[j]; VX[j] = hv; \
            hm_ = fmaxf(fmaxf(hm_, fmaxf(fabsf(hv.x), fabsf(hv.y))), fmaxf(fabsf(hv.z), fabsf(hv.w))); } \
        hm_ = wave_max(hm_); const float inv_ = hm_ > 0.f ? 127.0f / hm_ : 0.f; \
        unsigned* hr_ = (unsigned*)((unsigned char*)H2 + (size_t)(M) * DM) + lane; \
        _Pragma("unroll") for (int j = 0; j < 8; ++j) hr_[64 * j] = pack_i8x4(VX[j].x * inv_, VX[j].y * inv_, VX[j].z * inv_, VX[j].w * inv_); \
        if (lane == 0) SA[M] = hm_ * (1.0f / 127.0f); } while (0)
        for (int b = 0; b < NBATCH; ++b) {
            const float* mb = MOD + b * NMOD; const int mend = (b + 1) * SEQ;
            f32x4 A1[8], A2[8], B2[8];
#pragma unroll
            for (int j = 0; j < 8; ++j) { const int col = 4 * (lane + 64 * j);
                A1[j] = *(const f32x4*)(mb + 2 * DM + col) * *(const f32x4*)(gpost + col);
                A2[j] = *(const f32x4*)(gpre + col) * (*(const f32x4*)(mb + 4 * DM + col) + 1.0f); B2[j] = *(const f32x4*)(mb + 3 * DM + col); }
            f32x4 xa[8]; u32x2 ya[8];
            for (int m = b * SEQ + gw; m < mend; m += NGW) { P6_LOAD(xa, ya, m); P6_PROC(xa, ya, m); }
        }
#undef P6_LOAD
#undef P6_PROC
    }
    SEAM(6);

    for (int rep_ = 0; rep_ < NREP(7); ++rep_) if (IN(7)) {
        pg8::Gemm g{H2, WUP, DM / 2, DM / 2, DM / 2, H2, WUP}; pg8::Order S; S.init(MTOK / 256, DUP / 256, G, bid, 0);
        pg8::EpiUp E{ACT, HALO, args.in[I_CONVW], args.in[I_CONVB], SA, SB};
        pg8::gemm_phase<pg8::EpiUp, pg8::Order, true, true>(lds, g, S, E);
    }
    SEAM(7);

    for (int rep_ = 0; rep_ < NREP(8); ++rep_) if (IN(8)) {
        int tid = threadIdx.x; asm volatile("" : "+v"(tid)); const int lane = tid & 63; (void)lane;
        const float* cw = args.in[I_CONVW]; const float* cb = args.in[I_CONVB];
        constexpr int NC8 = DFF / 8;
        const int total = 512 * 2 * NC8;
        for (int it = bid * 512 + tid; it < total; it += G * 512) {
            const int cg8 = it % NC8, rs = it / NC8, side = rs & 1, k = rs >> 1;
            const int c0 = cg8 * 8, dcol = 256 * (c0 >> 7) + (c0 & 127);
            const bf16_t* hk = HALO + (size_t)k * 4 * DUP;
            u32x4 ma, mg, za, zg, pa, pg; const u32x4 zero = {0u, 0u, 0u, 0u};
            if (side == 0) {
                if ((k & 127) == 0) { ma = zero; mg = zero; } else { const bf16_t* hm = hk - 4 * DUP + 3 * DUP; ma = *(const u32x4*)(hm + dcol); mg = *(const u32x4*)(hm + dcol + 128); }
                za = *(const u32x4*)(hk + dcol); zg = *(const u32x4*)(hk + dcol + 128);
                pa = *(const u32x4*)(hk + DUP + dcol); pg = *(const u32x4*)(hk + DUP + dcol + 128);
            } else {
                ma = *(const u32x4*)(hk + 2 * DUP + dcol); mg = *(const u32x4*)(hk + 2 * DUP + dcol + 128);
                za = *(const u32x4*)(hk + 3 * DUP + dcol); zg = *(const u32x4*)(hk + 3 * DUP + dcol + 128);
                if ((k & 127) == 127) { pa = zero; pg = zero; } else { const bf16_t* hn = hk + 4 * DUP; pa = *(const u32x4*)(hn + dcol); pg = *(const u32x4*)(hn + dcol + 128); }
            }
            float res[8];
#pragma unroll
            for (int e = 0; e < 8; ++e) {
                const unsigned wm_a = ma[e >> 1], wz_a = za[e >> 1], wp_a = pa[e >> 1], wm_g = mg[e >> 1], wz_g = zg[e >> 1], wp_g = pg[e >> 1];
                const float am = (e & 1) ? bf_hi(wm_a) : bf_lo(wm_a), az = (e & 1) ? bf_hi(wz_a) : bf_lo(wz_a), ap = (e & 1) ? bf_hi(wp_a) : bf_lo(wp_a);
                const float gm = (e & 1) ? bf_hi(wm_g) : bf_lo(wm_g), gz = (e & 1) ? bf_hi(wz_g) : bf_lo(wz_g), gp = (e & 1) ? bf_hi(wp_g) : bf_lo(wp_g);
                const int ca = c0 + e, cgc = DFF + c0 + e;
                const float va = cb[ca] + cw[ca] * am + cw[DUP + ca] * az + cw[2 * DUP + ca] * ap;
                const float vg = cb[cgc] + cw[cgc] * gm + cw[DUP + cgc] * gz + cw[2 * DUP + cgc] * gp;
                res[e] = va * vg * sigmoidf_(vg);
            }
            u32x4 w; w.x = cvt_pk_bf16(res[0], res[1]); w.y = cvt_pk_bf16(res[2], res[3]); w.z = cvt_pk_bf16(res[4], res[5]); w.w = cvt_pk_bf16(res[6], res[7]);
            const int row = k * 64 + (side ? 63 : 0);
            *(u32x4*)(ACT + (size_t)row * DFF + c0) = w;
        }
    }
    SEAM(8);

    for (int rep_ = 0; rep_ < NREP(9); ++rep_) if (IN(9)) {
        pg8::Gemm g{ACT, WDN, DFF, DFF, DFF, ACT, WDN}; pg8::Order S; S.init(MTOK / 256, DM / 256, G, bid, 0);
        pg8::EpiBf16 E{F, DM};
        pg8::gemm_phase<pg8::EpiBf16, pg8::Order, true, true>(lds, g, S, E);
    }
    SEAM(9);

    for (int rep_ = 0; rep_ < NREP(10); ++rep_) if (IN(10)) {
        int tid = threadIdx.x; asm volatile("" : "+v"(tid)); const int lane = tid & 63; (void)lane;
        const float* gpost = args.in[I_GFPOST]; const float* gpost1 = args.in[I_GAPOST]; const float* x = args.in[I_X];
#define PA_LOAD(VX, VY, VF, M) do { const f32x4* xr_ = (const f32x4*)(x + (size_t)(M) * DM) + lane; const u32x2* yr_ = (const u32x2*)(Y + (size_t)(M) * DM) + lane; const u32x2* fr_ = (const u32x2*)(F + (size_t)(M) * DM) + lane; \
        _Pragma("unroll") for (int j = 0; j < 8; ++j) VY[j] = yr_[64 * j]; \
        _Pragma("unroll") for (int j = 0; j < 8; ++j) VF[j] = fr_[64 * j]; \
        _Pragma("unroll") for (int j = 0; j < 8; ++j) VX[j] = __builtin_nontemporal_load(xr_ + 64 * j); } while (0)
#define PA_PROC(VX, VY, VF, M) do { float ss_ = 0.f, sy_ = 0.f; \
        _Pragma("unroll") for (int j = 0; j < 8; ++j) { const float y0 = bf_lo(VY[j].x), y1 = bf_hi(VY[j].x), y2 = bf_lo(VY[j].y), y3 = bf_hi(VY[j].y); sy_ += (y0 * y0 + y1 * y1) + (y2 * y2 + y3 * y3); } \
        _Pragma("unroll") for (int j = 0; j < 8; ++j) { const float y0 = bf_lo(VF[j].x), y1 = bf_hi(VF[j].x), y2 = bf_lo(VF[j].y), y3 = bf_hi(VF[j].y); ss_ += (y0 * y0 + y1 * y1) + (y2 * y2 + y3 * y3); } \
        const float rstdy_ = 1.0f / sqrtf(wave_sum(sy_) * (1.0f / DM) + EPS); \
        const float rstd_ = 1.0f / sqrtf(wave_sum(ss_) * (1.0f / DM) + EPS); \
        f32x4* orow_ = (f32x4*)(args.out + (size_t)(M) * DM) + lane; \
        _Pragma("unroll") for (int j = 0; j < 8; ++j) { \
            const f32x4 yv = {bf_lo(VY[j].x), bf_hi(VY[j].x), bf_lo(VY[j].y), bf_hi(VY[j].y)}; \
            const f32x4 fv = {bf_lo(VF[j].x), bf_hi(VF[j].x), bf_lo(VF[j].y), bf_hi(VF[j].y)}; \
            const f32x4 x1 = VX[j] + A1[j] * (yv * rstdy_); \
            __builtin_nontemporal_store(x1 + A3[j] * (fv * rstd_), orow_ + 64 * j); } } while (0)
        for (int b = 0; b < NBATCH; ++b) {
            const float* mb = MOD + b * NMOD; const int mend = (b + 1) * SEQ;
            f32x4 A1[8], A3[8];
#pragma unroll
            for (int j = 0; j < 8; ++j) { const int col = 4 * (lane + 64 * j);
                A1[j] = *(const f32x4*)(mb + 2 * DM + col) * *(const f32x4*)(gpost1 + col);
                A3[j] = *(const f32x4*)(mb + 5 * DM + col) * *(const f32x4*)(gpost + col); }
            f32x4 xa[8]; u32x2 ya[8], fa[8];
            for (int m = b * SEQ + gw; m < mend; m += NGW) { PA_LOAD(xa, ya, fa, m); PA_PROC(xa, ya, fa, m); }
        }
#undef PA_LOAD
#undef PA_PROC
    }
#undef IN
#undef SEAM
}

extern "C" void kernel_launch(void* const* d_in, const int* in_sizes, int n_in, void* d_out, int out_size, void* d_ws, size_t ws_size, hipStream_t stream) {
    static int grid = 0;
    if (grid == 0) {
        if (n_in != 20 || in_sizes[0] != MTOK * DM || out_size != MTOK * DM || ws_size < WS_END) {
            fprintf(stderr, "kernel_launch: unexpected shapes: n_in %d in0 %d out %d ws %zu (need >= %zu)\n", n_in, n_in > 0 ? in_sizes[0] : -1, out_size, ws_size, (size_t)WS_END); grid = -1; return; }
        int dev = 0, cus = 0, per_cu = 0;
        if (hipGetDevice(&dev) != hipSuccess || hipDeviceGetAttribute(&cus, hipDeviceAttributeMultiprocessorCount, dev) != hipSuccess) { fprintf(stderr, "kernel_launch: device query failed\n"); grid = -1; return; }
        if (hipFuncSetAttribute((const void*)fwd_mega, hipFuncAttributeMaxDynamicSharedMemorySize, LDS_BYTES) != hipSuccess) { fprintf(stderr, "kernel_launch: hipFuncSetAttribute failed\n"); grid = -1; return; }
        if (hipOccupancyMaxActiveBlocksPerMultiprocessor(&per_cu, (const void*)fwd_mega, 512, LDS_BYTES) != hipSuccess || per_cu < 1) { fprintf(stderr, "kernel_launch: occupancy query says %d\n", per_cu); per_cu = 1; }
        (void)hipGetLastError();
        grid = cus * 1;
        if (grid != 256) fprintf(stderr, "kernel_launch: note: %d CUs\n", cus);
    }
    if (grid < 0) return;
    if (hipMemsetAsync(d_ws, 0, CTL_ZERO_BYTES, stream) != hipSuccess) { fprintf(stderr, "kernel_launch: memset failed\n"); return; }
    if (hipMemsetAsync((char*)d_ws + WS_CM, 0, 64 * 1024, stream) != hipSuccess) { fprintf(stderr, "kernel_launch: memset 2 failed\n"); return; }
    Args a{};
    for (int i = 0; i < 20; ++i) a.in[i] = (const float*)d_in[i];
    a.out = (float*)d_out; a.ws = (unsigned char*)d_ws;
#if MK_N_LAUNCHES == 1
    a.ph_lo = 0; a.ph_hi = NPHASE;
    void* kargs[] = {&a};
    hipError_t e = hipLaunchCooperativeKernel((const void*)fwd_mega, dim3(grid), dim3(512), kargs, LDS_BYTES, stream);
    if (e != hipSuccess) fprintf(stderr, "kernel_launch: cooperative launch failed: %s (grid %d)\n", hipGetErrorString(e), grid);
#else
    for (int p = 0; p < NPHASE; ++p) { a.ph_lo = p; a.ph_hi = p + 1;
        hipLaunchKernelGGL(fwd_mega, dim3(grid), dim3(512), LDS_BYTES, stream, a);
        const hipError_t le = hipPeekAtLastError(); if (le != hipSuccess) { fprintf(stderr, "kernel_launch: launch %d failed: %s\n", p, hipGetErrorName(le)); break; } }
#endif
}
```
